# Optimizing an MI355X kernel written in HIP

```python
import math
import jax
import jax.numpy as jnp
from jax import lax
import numpy as np

D_MODEL = 1024
BATCH = 32
SEQ = 256
DEPTH = 2
DEC_BATCH = 4
DEC_SEQ = 4096
PAST_LEN = 512

GRID_W = 64
MIX_WIDTH = D_MODEL
A_WIDTH = MIX_WIDTH // 2
B_WIDTH = MIX_WIDTH - A_WIDTH
DK = 128
DV = 128
H_A = A_WIDTH // DV
N_DIR = 2
CHUNK = 64
N_POOL_GROUPS = 4
POOL_GROUP = D_MODEL // N_POOL_GROUPS
POOL_WINDOWS = (2, 4, 8, 16)
D_FF = 2816
N_MOD = 6
N_EVEN = (DEPTH + 1) // 2
N_ODD = DEPTH // 2
EPS = 1e-6
DT_MIN = 0.001
DT_MAX = 0.1
QKV_END = 3 * A_WIDTH
GATE_END = QKV_END + A_WIDTH
BETA_END = GATE_END + N_DIR * H_A
ALPHA_END = BETA_END + N_DIR * H_A
BG_END = ALPHA_END + B_WIDTH
CG_END = BG_END + B_WIDTH
IN_AB = CG_END + B_WIDTH

kernel_name = "hybrid_deltanet_shortconv_pool_diffusion_step"


def rmsnorm(x, g):
    x32 = x.astype(jnp.float32)
    y = x32 * lax.rsqrt(jnp.mean(x32 * x32, axis=-1, keepdims=True) + EPS)
    return (y * g.astype(jnp.float32)).astype(x.dtype)


def l2norm(x):
    return x * lax.rsqrt(jnp.sum(x * x, axis=-1, keepdims=True) + EPS)


def dwconv3(x, w):
    xp = jnp.pad(x, ((0, 0), (1, 1), (0, 0)))
    return xp[:, :-2] * w[0] + xp[:, 1:-1] * w[1] + xp[:, 2:] * w[2]


def sincos_2d(rows, cols, d):
    quarter = d // 4
    omega = 1.0 / (10000.0 ** (jnp.arange(quarter, dtype=jnp.float32) / quarter))
    er = jnp.arange(rows, dtype=jnp.float32)[:, None] * omega[None, :]
    ec = jnp.arange(cols, dtype=jnp.float32)[:, None] * omega[None, :]
    er = jnp.concatenate([jnp.sin(er), jnp.cos(er)], axis=-1)
    ec = jnp.concatenate([jnp.sin(ec), jnp.cos(ec)], axis=-1)
    pe = jnp.concatenate([jnp.broadcast_to(er[:, None, :], (rows, cols, d // 2)),
                          jnp.broadcast_to(ec[None, :, :], (rows, cols, d // 2))], axis=-1)
    return pe.reshape(rows * cols, d)


def _to_chunks(t):
    b, l, h = t.shape[:3]
    t = t.reshape((b, l // CHUNK, CHUNK, h) + t.shape[3:])
    return jnp.moveaxis(t, 3, 1)


def chunk_gated_delta(q, k, v, g, beta, s0):
    f32 = jnp.float32
    b, l, h, dk = q.shape
    dv = v.shape[-1]
    q = _to_chunks(q.astype(f32) * (dk ** -0.5))
    k = _to_chunks(k.astype(f32))
    v = _to_chunks(v.astype(f32))
    beta = _to_chunks(beta.astype(f32))
    gc = jnp.cumsum(_to_chunks(g.astype(f32)), axis=-1)
    tri = jnp.tril(jnp.ones((CHUNK, CHUNK), dtype=bool))
    strict = jnp.tril(jnp.ones((CHUNK, CHUNK), dtype=bool), k=-1)
    decay = jnp.exp(jnp.where(tri, gc[..., :, None] - gc[..., None, :], -jnp.inf))
    kb = k * beta[..., None]
    vb = v * beta[..., None]
    m = jnp.where(strict, jnp.einsum("bhncd,bhnsd->bhncs", kb, k) * decay, 0.0)
    a = m + jnp.eye(CHUNK, dtype=f32)
    u = lax.linalg.triangular_solve(a, vb, left_side=True, lower=True, unit_diagonal=True)
    w = lax.linalg.triangular_solve(a, kb * jnp.exp(gc)[..., None], left_side=True,
                                    lower=True, unit_diagonal=True)
    attn = jnp.where(tri, jnp.einsum("bhncd,bhnsd->bhncs", q, k) * decay, 0.0)
    qg = q * jnp.exp(gc)[..., None]
    kg = k * jnp.exp(gc[..., -1:] - gc)[..., None]
    g_last = jnp.exp(gc[..., -1])
    xs = tuple(jnp.moveaxis(t, 2, 0) for t in (qg, kg, u, w, attn, g_last))

    def step(s, inp):
        qg_i, kg_i, u_i, w_i, attn_i, gl_i = inp
        v_new = u_i - jnp.einsum("bhcd,bhde->bhce", w_i, s)
        o_i = (jnp.einsum("bhcd,bhde->bhce", qg_i, s)
               + jnp.einsum("bhcs,bhse->bhce", attn_i, v_new))
        s = s * gl_i[..., None, None] + jnp.einsum("bhcd,bhce->bhde", kg_i, v_new)
        return s, o_i

    s_fin, o = lax.scan(step, s0.astype(f32), xs)
    o = jnp.transpose(o, (1, 0, 3, 2, 4)).reshape(b, l, h, dv)
    return o, s_fin


def mixer_ab(h, s0, w_in, conv_qkv, a_log, dt_bias, o_norm_g, conv_b, w_out):
    b, l, _ = h.shape
    p = h @ w_in
    qkv = jax.nn.silu(dwconv3(p[..., :QKV_END], conv_qkv))
    q = l2norm(qkv[..., :A_WIDTH].reshape(b, l, H_A, DK).astype(jnp.float32))
    k = l2norm(qkv[..., A_WIDTH:2 * A_WIDTH].reshape(b, l, H_A, DK).astype(jnp.float32))
    v = qkv[..., 2 * A_WIDTH:QKV_END].reshape(b, l, H_A, DV)
    gate = p[..., QKV_END:GATE_END].reshape(b, l, H_A, DV).astype(jnp.float32)
    beta = jax.nn.sigmoid(p[..., GATE_END:BETA_END].astype(jnp.float32)).reshape(b, l, N_DIR, H_A)
    alpha = p[..., BETA_END:ALPHA_END].astype(jnp.float32).reshape(b, l, N_DIR, H_A)
    g = -jnp.exp(a_log.astype(jnp.float32)) * jax.nn.softplus(alpha + dt_bias.astype(jnp.float32))
    o_f, s_f = chunk_gated_delta(q, k, v, g[:, :, 0], beta[:, :, 0], s0[:, 0])
    flip = lambda t: jnp.flip(t, axis=1)
    o_b, s_b = chunk_gated_delta(flip(q), flip(k), flip(v), flip(g[:, :, 1]),
                                 flip(beta[:, :, 1]), s0[:, 1])
    o = rmsnorm(o_f + flip(o_b), o_norm_g) * jax.nn.silu(gate)
    o_a = o.reshape(b, l, A_WIDTH).astype(h.dtype)
    bg = p[..., ALPHA_END:BG_END]
    cg = p[..., BG_END:CG_END]
    hx = p[..., CG_END:IN_AB]
    y_b = bg * dwconv3(cg * hx, conv_b)
    y = jnp.concatenate([o_a, y_b], axis=-1) @ w_out
    return y, jnp.stack([s_f, s_b], axis=1).astype(h.dtype)


def multiscale_pool(h, w_pool, scale):
    b, l, d = h.shape
    hg = h.reshape(b, l, N_POOL_GROUPS, POOL_GROUP).astype(jnp.float32)
    cs = jnp.concatenate([jnp.zeros((b, 1, N_POOL_GROUPS, POOL_GROUP), jnp.float32),
                          jnp.cumsum(hg, axis=1)], axis=1)
    t = jnp.arange(l)
    means = []
    for gi, win in enumerate(POOL_WINDOWS):
        lo = jnp.clip(t - win // 2, 0, l)
        hi = jnp.clip(t - win // 2 + win, 0, l)
        s = cs[:, hi, gi] - cs[:, lo, gi]
        means.append(s / (hi - lo).astype(jnp.float32)[None, :, None])
    mixed = (jnp.stack(means, axis=2) - hg).astype(h.dtype)
    y = jnp.einsum("blgc,gcd->blgd", mixed, w_pool).reshape(b, l, d)
    return y * scale


def conv_ffn(h, w_gate, w_up, conv, w_down):
    u = dwconv3(h @ w_gate, conv)
    return (jax.nn.silu(u) * (h @ w_up)) @ w_down


def setup_inputs(seed: int = 0) -> dict:
    key = jax.random.key(seed)
    ks = jax.random.split(key, 24)
    f32 = jnp.float32

    def nrm(k, shape, s):
        return jax.random.normal(k, shape, f32) * s

    dt = jnp.exp(jax.random.uniform(ks[9], (N_EVEN, N_DIR, H_A), f32)
                 * (math.log(DT_MAX) - math.log(DT_MIN)) + math.log(DT_MIN))
    dt_bias = dt + jnp.log(-jnp.expm1(-dt))
    a_log = jnp.log(jax.random.uniform(ks[10], (N_EVEN, N_DIR, H_A), f32, 1.0, 16.0))
    return {
        "x_prompt": nrm(ks[0], (BATCH, SEQ, D_MODEL), 1.0),
        "x_sample": nrm(ks[1], (DEC_BATCH, DEC_SEQ, D_MODEL), 1.0),
        "state_delta": nrm(ks[2], (DEC_BATCH, N_EVEN, N_DIR, H_A, DK, DV), 0.05),
        "c": nrm(ks[3], (DEC_BATCH, D_MODEL), 1.0),
        "c_ctx": nrm(ks[4], (D_MODEL,), 1.0),
        "norm_mix_g": 1.0 + nrm(ks[5], (DEPTH, D_MODEL), 0.05),
        "norm_ffn_g": 1.0 + nrm(ks[6], (DEPTH, D_MODEL), 0.05),
        "w_ada": nrm(ks[7], (DEPTH, D_MODEL, N_MOD * D_MODEL), 0.5 * D_MODEL ** -0.5),
        "b_ada": nrm(ks[8], (DEPTH, N_MOD * D_MODEL), 0.02),
        "w_in_ab": nrm(ks[11], (N_EVEN, D_MODEL, IN_AB), D_MODEL ** -0.5),
        "conv_qkv": nrm(ks[12], (N_EVEN, 3, QKV_END), 3 ** -0.5),
        "a_log": a_log,
        "dt_bias": dt_bias,
        "o_norm_g": 1.0 + nrm(ks[13], (N_EVEN, DV), 0.05),
        "conv_b": nrm(ks[14], (N_EVEN, 3, B_WIDTH), 3 ** -0.5),
        "w_out_ab": nrm(ks[15], (N_EVEN, MIX_WIDTH, D_MODEL), MIX_WIDTH ** -0.5),
        "w_pool": nrm(ks[16], (N_ODD, N_POOL_GROUPS, POOL_GROUP, POOL_GROUP), POOL_GROUP ** -0.5),
        "pool_scale": 1.0 + nrm(ks[17], (N_ODD, D_MODEL), 0.1),
        "w_ffn_gate": nrm(ks[18], (DEPTH, D_MODEL, D_FF), D_MODEL ** -0.5),
        "w_ffn_up": nrm(ks[19], (DEPTH, D_MODEL, D_FF), D_MODEL ** -0.5),
        "ffn_conv": nrm(ks[20], (DEPTH, 3, D_FF), 3 ** -0.5),
        "w_ffn_down": nrm(ks[21], (DEPTH, D_FF, D_MODEL), D_FF ** -0.5),
        "final_norm_g": 1.0 + nrm(ks[22], (D_MODEL,), 0.05),
    }


def reference(x_prompt, x_sample, state_delta, c, c_ctx, norm_mix_g, norm_ffn_g, w_ada, b_ada,
              w_in_ab, conv_qkv, a_log, dt_bias, o_norm_g, conv_b, w_out_ab, w_pool, pool_scale,
              w_ffn_gate, w_ffn_up, ffn_conv, w_ffn_down, final_norm_g):

    def trunk(x, cond, states, is_context):
        finals = []
        for layer in range(DEPTH):
            mod = jax.nn.silu(cond) @ w_ada[layer] + b_ada[layer]
            shift1, scale1, gate1, shift2, scale2, gate2 = jnp.split(mod[:, None, :], N_MOD, axis=-1)
            h = rmsnorm(x, norm_mix_g[layer]) * (1 + scale1) + shift1
            if layer % 2 == 0:
                e = layer // 2
                y, s_fin = mixer_ab(h, states[:, e], w_in_ab[e], conv_qkv[e], a_log[e],
                                    dt_bias[e], o_norm_g[e], conv_b[e], w_out_ab[e])
                if is_context:
                    finals.append(s_fin)
            else:
                o = layer // 2
                y = multiscale_pool(h, w_pool[o], pool_scale[o])
            x = x + gate1 * y
            h = rmsnorm(x, norm_ffn_g[layer]) * (1 + scale2) + shift2
            x = x + gate2 * conv_ffn(h, w_ffn_gate[layer], w_ffn_up[layer], ffn_conv[layer],
                                     w_ffn_down[layer])
        return rmsnorm(x, final_norm_g), finals

    zero_states = jnp.zeros((x_prompt.shape[0], N_EVEN, N_DIR, H_A, DK, DV), x_prompt.dtype)
    y_prompt, finals = trunk(x_prompt, c_ctx[None, :], zero_states, True)
    new_state_delta = jnp.stack(finals, axis=1)

    rows = x_sample.shape[1] // GRID_W
    x_lat = x_sample + sincos_2d(rows, GRID_W, D_MODEL).astype(x_sample.dtype)[None]
    y_sample, _ = trunk(x_lat, c, state_delta, False)

    return (y_prompt, y_sample, new_state_delta)
```

```cpp
#include <hip/hip_runtime.h>
#include <hip/hip_cooperative_groups.h>
#include <cstdio>
namespace cg = cooperative_groups;

#ifndef COOP
#define COOP 1
#endif
#ifndef STOP_AFTER
#define STOP_AFTER 13
#endif


typedef unsigned short bf16_t;
typedef unsigned int u32;
typedef short bf16x8 __attribute__((ext_vector_type(8)));
typedef float f32x4 __attribute__((ext_vector_type(4)));
typedef u32 u32x4 __attribute__((ext_vector_type(4)));
typedef u32 u32x2 __attribute__((ext_vector_type(2)));

constexpr int NTOK = 24576, NCTX = 8192;
constexpr int NTHREADS = 512;
constexpr float EPSF = 1e-6f;
constexpr int LDS_TILE_BYTES = 256 * 544;
constexpr int LDS_BYTES = LDS_TILE_BYTES + 16;

constexpr size_t OFF_WIN = 0;
constexpr size_t OFF_WOUT = OFF_WIN + (size_t)3584 * 1024 * 2;
constexpr size_t OFF_WPOOL = OFF_WOUT + (size_t)1024 * 1024 * 2;
constexpr size_t OFF_WGU = OFF_WPOOL + (size_t)4 * 256 * 256 * 2;
constexpr size_t OFF_WDN = OFF_WGU + (size_t)2 * 5632 * 1024 * 2;
constexpr size_t OFF_SMALL = OFF_WDN + (size_t)2 * 1024 * 2816 * 2;
constexpr size_t OFF_MOD = OFF_SMALL;
constexpr size_t OFF_SW = OFF_MOD + (size_t)2 * 5 * 6144 * 4;
constexpr size_t OFF_PE = OFF_SW + (size_t)2 * 5 * 5632 * 4;
constexpr size_t OFF_G = OFF_PE + (size_t)64 * 512 * 4;
constexpr size_t OFF_BETA = OFF_G + (size_t)NTOK * 8 * 4;
constexpr size_t OFF_RSQ = OFF_BETA + (size_t)NTOK * 8 * 4;
constexpr size_t OFF_BAR = OFF_RSQ + (size_t)4 * NTOK * 4;
constexpr size_t OFF_R1 = OFF_SMALL + (size_t)4 * 1024 * 1024;
constexpr size_t SZ_R1 = (size_t)NTOK * 1024 * 2;
constexpr size_t OFF_BIG = OFF_R1 + SZ_R1;
constexpr size_t SZ_QKV = (size_t)NTOK * 512 * 2;
constexpr size_t OFF_Q = OFF_BIG, OFF_K = OFF_Q + SZ_QKV, OFF_V = OFF_K + SZ_QKV, OFF_GS = OFF_V + SZ_QKV, OFF_CAT = OFF_GS + SZ_QKV;
constexpr size_t OFF_ACT = OFF_BIG;
constexpr size_t OFF_TP = OFF_R1, OFF_AP = OFF_TP + (size_t)1536 * 4096 * 2, OFF_OB = OFF_AP + (size_t)1536 * 4096 * 2;

struct P {
  const float *x_prompt, *x_sample, *state, *c, *c_ctx, *norm_mix_g, *norm_ffn_g, *w_ada, *b_ada, *w_in, *conv_qkv, *a_log, *dt_bias,
      *o_norm_g, *conv_b, *w_out, *w_pool, *pool_scale, *w_gate, *w_up, *ffn_conv, *w_down, *final_g;
  float* out;
  char* ws;
  int phase_lo, phase_hi;
  int nblk, wv;
};

extern __shared__ __attribute__((aligned(1024))) char g_shm[];

typedef __bf16 bf16x2v __attribute__((ext_vector_type(2)));
typedef float f32x2v __attribute__((ext_vector_type(2)));
__device__ __forceinline__ u32 pk_bf16(float lo, float hi) { f32x2v f = {lo, hi}; bf16x2v b = __builtin_convertvector(f, bf16x2v); return __builtin_bit_cast(u32, b); }
__device__ __forceinline__ float bf_lo(u32 w) { return __uint_as_float(w << 16); }
__device__ __forceinline__ float bf_hi(u32 w) { return __uint_as_float(w & 0xffff0000u); }
__device__ __forceinline__ float bf2f(bf16_t v) { return __uint_as_float(((u32)v) << 16); }
__device__ __forceinline__ float silu_f(float x) { return x * __builtin_amdgcn_rcpf(1.f + __expf(-x)); }
__device__ __forceinline__ float sigm_f(float x) { return __builtin_amdgcn_rcpf(1.f + __expf(-x)); }
__device__ __forceinline__ void unpack8(u32x4 v, float (&o)[8]) {
  o[0] = bf_lo(v[0]); o[1] = bf_hi(v[0]); o[2] = bf_lo(v[1]); o[3] = bf_hi(v[1]);
  o[4] = bf_lo(v[2]); o[5] = bf_hi(v[2]); o[6] = bf_lo(v[3]); o[7] = bf_hi(v[3]);
}
__device__ __forceinline__ u32x4 pack8(const float (&o)[8]) {
  u32x4 v; v[0] = pk_bf16(o[0], o[1]); v[1] = pk_bf16(o[2], o[3]); v[2] = pk_bf16(o[4], o[5]); v[3] = pk_bf16(o[6], o[7]); return v;
}
template <int CTRL> __device__ __forceinline__ float dpp_mov(float v) {
  return __builtin_bit_cast(float, __builtin_amdgcn_update_dpp(0, __builtin_bit_cast(int, v), CTRL, 0xF, 0xF, true));
}
__device__ __forceinline__ float sum16(float v) {
  v += dpp_mov<0xB1>(v);
  v += dpp_mov<0x4E>(v);
  v += dpp_mov<0x141>(v);
  v += dpp_mov<0x140>(v);
  return v;
}
__device__ __forceinline__ float rdlane(float v, int l) { return __builtin_bit_cast(float, __builtin_amdgcn_readlane(__builtin_bit_cast(int, v), l)); }
__device__ __forceinline__ float wave_sum(float v) {
  v = sum16(v);
  return (rdlane(v, 0) + rdlane(v, 16)) + (rdlane(v, 32) + rdlane(v, 48));
}
template <int CTRL, int ROWMASK> __device__ __forceinline__ float dpp_add(float v) {
  return v + __builtin_bit_cast(float, __builtin_amdgcn_update_dpp(0, __builtin_bit_cast(int, v), CTRL, ROWMASK, 0xF, CTRL < 0x140));
}
__device__ __forceinline__ float wave_prefix(float g, int  ) {
  g = dpp_add<0x111, 0xF>(g);
  g = dpp_add<0x112, 0xF>(g);
  g = dpp_add<0x114, 0xF>(g);
  g = dpp_add<0x118, 0xF>(g);
  g = dpp_add<0x142, 0xA>(g);
  g = dpp_add<0x143, 0xC>(g);
  return g;
}
#define GRIDX() (p.nblk)
__device__ __forceinline__ int BIDX() { return (int)blockIdx.x; }
__device__ __forceinline__ int opaque_tid_w(int wv) { unsigned m = ~0u; asm volatile("" : "+s"(m)); int t = (wv << 6) | (int)__builtin_amdgcn_mbcnt_hi(m, __builtin_amdgcn_mbcnt_lo(m, 0u)); asm volatile("" : "+v"(t)); return t; }
#define opaque_tid() opaque_tid_w(p.wv)
__device__ __forceinline__ int row_cond(int row) { return row < NCTX ? 0 : 1 + ((row - NCTX) >> 12); }


#define XB_TMO      128
#define XB_XCNT(j)  (256  + 64 * (j))
#define XB_XSUB(j)  (1280 + 64 * (j))
#define XB_XGEN(j)  (2304 + 64 * (j))
#define XB_TOP      3328
#define XB_TOPGEN   3392
#define XCD_BAR_WORDS 3456
#define XB_SPIN_CAP (1u << 18)
#define LAS __attribute__((address_space(3)))
__device__ __forceinline__ unsigned xb_ld(unsigned* q)              { return __hip_atomic_load(q, __ATOMIC_RELAXED, __HIP_MEMORY_SCOPE_AGENT); }
__device__ __forceinline__ unsigned xb_add(unsigned* q, unsigned v) { return __hip_atomic_fetch_add(q, v, __ATOMIC_RELAXED, __HIP_MEMORY_SCOPE_AGENT); }
__device__ __forceinline__ unsigned xb_xcc_id() { return (unsigned)__builtin_amdgcn_s_getreg((3 << 11) | 20) & 0xFu; }
#define XB_SPIN(cond, bar) do { unsigned _sp = 0; while (cond) { __builtin_amdgcn_s_sleep(1); \
    if ((++_sp & 255u) == 0u) { if (xb_ld(&(bar)[XB_TMO])) break; if (_sp > XB_SPIN_CAP) { atomicAdd(&(bar)[XB_TMO], 1u); break; } } } } while (0)
__device__ __forceinline__ void xb_complete(unsigned* bar, unsigned x, unsigned G, unsigned& nloc, unsigned& nx) {
  unsigned sum, cnt, mine, sp = 0u;
  for (;;) {
    sum = 0u; cnt = 0u; mine = 0u;
#pragma unroll
    for (unsigned j = 0; j < 16; ++j) { const unsigned c = xb_ld(&bar[XB_XCNT(j)]); sum += c; cnt += (c > 0u) ? 1u : 0u; mine = (j == x) ? c : mine; }
    if (sum == G) break;
    __builtin_amdgcn_s_sleep(1);
    if ((++sp & 255u) == 0u) { if (xb_ld(&bar[XB_TMO])) break; if (sp > XB_SPIN_CAP) { atomicAdd(&bar[XB_TMO], 1u); break; } }
  }
  nloc = mine > 0u ? mine : 1u; nx = cnt > 0u ? cnt : 1u;
}
__device__ __forceinline__ void grid_bar_init(const P& p) {
  const int tid = opaque_tid();
  volatile LAS unsigned* st = (volatile LAS unsigned*)(g_shm + LDS_TILE_BYTES);
  if (tid == 0) { st[0] = 0u; st[1] = 0u; (void)xb_add(&((unsigned*)(p.ws + OFF_BAR))[XB_XCNT(xb_xcc_id())], 1u); }
  __syncthreads();
}
__device__ __forceinline__ void grid_bar(const P& p) {
  const int tid = opaque_tid();
  asm volatile("s_waitcnt vmcnt(0)" ::: "memory");
  __syncthreads();
  if (tid == 0) {
    unsigned* bar = (unsigned*)(p.ws + OFF_BAR);
    volatile LAS unsigned* st = (volatile LAS unsigned*)(g_shm + LDS_TILE_BYTES);
    const unsigned x = xb_xcc_id();
    __builtin_amdgcn_s_waitcnt(0);
    unsigned nloc = st[0], nx = st[1];
    if (nloc == 0u) { xb_complete(bar, x, (unsigned)p.nblk, nloc, nx); st[0] = nloc; st[1] = nx; }
    const unsigned old = xb_add(&bar[XB_XSUB(x)], 1u);
    const unsigned gen = old / nloc;
    if (old + 1u == (gen + 1u) * nloc) {
      __builtin_amdgcn_fence(__ATOMIC_RELEASE, "agent");
      asm volatile("s_waitcnt vmcnt(0)" ::: "memory");
      const unsigned og = xb_add(&bar[XB_TOP], 1u);
      const unsigned tg = og / nx;
      if (og + 1u == (tg + 1u) * nx) xb_add(&bar[XB_TOPGEN], 1u);
      else XB_SPIN(xb_ld(&bar[XB_TOPGEN]) == tg, bar);
      __builtin_amdgcn_fence(__ATOMIC_ACQUIRE, "agent");
      xb_add(&bar[XB_XGEN(x)], 1u);
      asm volatile("s_waitcnt vmcnt(0)" ::: "memory");
    } else {
      XB_SPIN(xb_ld(&bar[XB_XGEN(x)]) == gen, bar);
      __builtin_amdgcn_fence(__ATOMIC_ACQUIRE, "agent");
      asm volatile("s_waitcnt vmcnt(0)" ::: "memory");
    }
  }
  __syncthreads();
}

struct CvtTile { const float* src; bf16_t* dst; int ld_src, ld_dst; };
__device__ __forceinline__ CvtTile cvt_desc(const P& p, int t) {
  bf16_t* Win = (bf16_t*)(p.ws + OFF_WIN); bf16_t* Wout = (bf16_t*)(p.ws + OFF_WOUT); bf16_t* Wpool = (bf16_t*)(p.ws + OFF_WPOOL);
  bf16_t* Wgu = (bf16_t*)(p.ws + OFF_WGU); bf16_t* Wdn = (bf16_t*)(p.ws + OFF_WDN);
  CvtTile d;
  if (t < 896) {
    int j = t >> 4, kc = t & 15, sc;
    if (j < 24) sc = j * 64; else { int jj = j - 24, m = jj >> 2, part = jj & 3; sc = (part == 0 ? 2064 : part == 1 ? 2576 : part == 2 ? 3088 : 1536) + m * 64; }
    d.src = p.w_in + (size_t)kc * 64 * 3600 + sc; d.ld_src = 3600; d.dst = Win + (size_t)j * 64 * 1024 + kc * 64; d.ld_dst = 1024;
  } else if (t < 1152) {
    int u = t - 896, j = u >> 4, kc = u & 15;
    d.src = p.w_out + (size_t)kc * 64 * 1024 + j * 64; d.ld_src = 1024; d.dst = Wout + (size_t)j * 64 * 1024 + kc * 64; d.ld_dst = 1024;
  } else if (t < 1216) {
    int u = t - 1152, g = u >> 4, j = (u >> 2) & 3, kc = u & 3;
    d.src = p.w_pool + (size_t)g * 65536 + (size_t)kc * 64 * 256 + j * 64; d.ld_src = 256; d.dst = Wpool + (size_t)g * 65536 + (size_t)j * 64 * 256 + kc * 64; d.ld_dst = 256;
  } else if (t < 4032) {
    int u = t - 1216, l = u / 1408, v = u % 1408, j = v >> 4, kc = v & 15, nt = j >> 2, part = j & 3;
    d.src = (part < 2 ? p.w_gate : p.w_up) + (size_t)l * 1024 * 2816 + (size_t)kc * 64 * 2816 + nt * 128 + (part & 1) * 64; d.ld_src = 2816;
    d.dst = Wgu + (size_t)l * 5632 * 1024 + (size_t)j * 64 * 1024 + kc * 64; d.ld_dst = 1024;
  } else {
    int u = t - 4032, l = u / 704, v = u % 704, j = v / 44, kc = v % 44;
    d.src = p.w_down + (size_t)l * 2816 * 1024 + (size_t)kc * 64 * 1024 + j * 64; d.ld_src = 1024;
    d.dst = Wdn + (size_t)l * 1024 * 2816 + (size_t)j * 64 * 2816 + kc * 64; d.ld_dst = 2816;
  }
  return d;
}
__device__ __forceinline__ void cvt_loop(const P& p, int t, const int tend, const int tstride, const int tid) {
  float* tile = (float*)g_shm;
  const int kk0 = tid >> 4, c4 = tid & 15, wn = tid >> 3, wkc = tid & 7;
  float4 v0, v1;
  if (t < tend) { CvtTile d = cvt_desc(p, t); v0 = *(const float4*)(d.src + (size_t)kk0 * d.ld_src + c4 * 4); v1 = *(const float4*)(d.src + (size_t)(kk0 + 32) * d.ld_src + c4 * 4); }
  while (t < tend) {
    const CvtTile d = cvt_desc(p, t);
    { float* q = tile + kk0 * 65 + c4 * 4; q[0] = v0.x; q[1] = v0.y; q[2] = v0.z; q[3] = v0.w;
      q = tile + (kk0 + 32) * 65 + c4 * 4; q[0] = v1.x; q[1] = v1.y; q[2] = v1.z; q[3] = v1.w; }
    const int tn = t + tstride;
    if (tn < tend) { CvtTile e = cvt_desc(p, tn); v0 = *(const float4*)(e.src + (size_t)kk0 * e.ld_src + c4 * 4); v1 = *(const float4*)(e.src + (size_t)(kk0 + 32) * e.ld_src + c4 * 4); }
    __syncthreads();
    { float o[8];
#pragma unroll
      for (int e = 0; e < 8; ++e) o[e] = tile[(wkc * 8 + e) * 65 + wn];
      *(u32x4*)(d.dst + (size_t)wn * d.ld_dst + wkc * 8) = pack8(o); }
    __syncthreads();
    t = tn;
  }
}

__device__ __forceinline__ void phase0(const P& p) {
  const int tid = opaque_tid();
  float* sl = (float*)g_shm;
  float* red = (float*)(g_shm + 20480);
#pragma unroll
  for (int i = tid; i < 5120; i += NTHREADS) { int c = i >> 10, k = i & 1023; float v = c == 0 ? p.c_ctx[k] : p.c[(c - 1) * 1024 + k]; sl[i] = silu_f(v); }
  __syncthreads();
  float* mod = (float*)(p.ws + OFF_MOD);
  for (int item = BIDX(); item < 256; item += GRIDX()) {
    const int gcol0 = item * 48, layer = gcol0 / 6144, n0 = gcol0 % 6144;
    if (tid < 504) {
      const int cgp = tid % 12, kg = tid / 12;
      float acc[5][4];
#pragma unroll
      for (int c = 0; c < 5; ++c)
#pragma unroll
        for (int e = 0; e < 4; ++e) acc[c][e] = 0.f;
      for (int k0 = kg; k0 < 1024; k0 += 42 * 8) {
        float4 w[8];
#pragma unroll
        for (int u = 0; u < 8; ++u) { const int k = k0 + 42 * u; w[u] = k < 1024 ? *(const float4*)(p.w_ada + ((size_t)layer * 1024 + k) * 6144 + n0 + cgp * 4) : make_float4(0.f, 0.f, 0.f, 0.f); }
#pragma unroll
        for (int u = 0; u < 8; ++u) {
          const int k = k0 + 42 * u;
          if (k < 1024) {
#pragma unroll
            for (int c = 0; c < 5; ++c) { float s = sl[c * 1024 + k]; acc[c][0] += s * w[u].x; acc[c][1] += s * w[u].y; acc[c][2] += s * w[u].z; acc[c][3] += s * w[u].w; }
          }
        }
      }
#pragma unroll
      for (int c = 0; c < 5; ++c)
#pragma unroll
        for (int e = 0; e < 4; ++e) red[(kg * 5 + c) * 48 + cgp * 4 + e] = acc[c][e];
    }
    __syncthreads();
    if (tid < 240) {
      int c = tid / 48, n = tid % 48; float s = 0.f;
      for (int kg = 0; kg < 42; ++kg) s += red[(kg * 5 + c) * 48 + n];
      mod[((size_t)layer * 5 + c) * 6144 + n0 + n] = s + p.b_ada[layer * 6144 + n0 + n];
    }
    __syncthreads();
  }
  cvt_loop(p, BIDX(), 1216, GRIDX(), tid);
  float* pe = (float*)(p.ws + OFF_PE);
  for (int idx = BIDX() * NTHREADS + tid; idx < 32768; idx += GRIDX() * NTHREADS) {
    int pp = idx >> 9, e = idx & 511, ee = e & 255;
    float omega = 1.0f / powf(10000.0f, (float)ee / 256.0f);
    float a = (float)pp * omega;
    pe[idx] = e < 256 ? sinf(a) : cosf(a);
  }
}

__device__ __forceinline__ void phase1(const P& p) {
  const int tid = opaque_tid(), lane = tid & 63, wid = tid >> 6;
  float* wl = (float*)g_shm;
  const float* mod = (const float*)(p.ws + OFF_MOD);
#pragma unroll 16
  for (int idx = tid; idx < 16384; idx += NTHREADS) { int k = idx >> 4, j = idx & 15; wl[j * 1024 + k] = p.w_in[(size_t)k * 3600 + 2048 + j]; }
  __syncthreads();
  const float* pe = (const float*)(p.ws + OFF_PE);
  bf16_t* h0 = (bf16_t*)(p.ws + OFF_R1);
  float* gb = (float*)(p.ws + OFF_G); float* bb = (float*)(p.ws + OFF_BETA);
  f32x4 Gv[4];
#pragma unroll
  for (int i = 0; i < 4; ++i) Gv[i] = *(const f32x4*)(p.norm_mix_g + i * 256 + lane * 4);
  for (int it = BIDX(); it < NTOK / 16; it += GRIDX()) {
    float h[2][16];
    const int rowA = it * 16 + wid * 2;
    const bool lat = rowA >= NCTX;
    const float* src = lat ? p.x_sample + (size_t)(rowA - NCTX) * 1024 : p.x_prompt + (size_t)rowA * 1024;
    const float* mc = mod + (size_t)row_cond(rowA) * 6144;
    f32x4 xv[2][4], scv[4], shv[4];
#pragma unroll
    for (int rr = 0; rr < 2; ++rr)
#pragma unroll
      for (int i = 0; i < 4; ++i) xv[rr][i] = *(const f32x4*)(src + rr * 1024 + i * 256 + lane * 4);
    if (lat) {
#pragma unroll
      for (int rr = 0; rr < 2; ++rr) {
        const int pos = (rowA + rr - NCTX) & 4095, pr = pos >> 6, pc = pos & 63;
#pragma unroll
        for (int i = 0; i < 4; ++i) { const int k = i * 256 + lane * 4; xv[rr][i] = xv[rr][i] + *(const f32x4*)(pe + (k < 512 ? pr * 512 + k : pc * 512 + k - 512)); }
      }
    }
#pragma unroll
    for (int i = 0; i < 4; ++i) { const int k = i * 256 + lane * 4; scv[i] = *(const f32x4*)(mc + 1024 + k); shv[i] = *(const f32x4*)(mc + k); }
#pragma unroll
    for (int rr = 0; rr < 2; ++rr) {
      const int row = rowA + rr;
      float ss = 0.f;
#pragma unroll
      for (int i = 0; i < 4; ++i) {
        const int k = i * 256 + lane * 4; const f32x4 v = xv[rr][i];
        { u32x2 xo; xo[0] = pk_bf16(v[0], v[1]); xo[1] = pk_bf16(v[2], v[3]); *(u32x2*)((bf16_t*)p.out + (size_t)row * 1024 + k) = xo; }
        ss += v[0] * v[0] + v[1] * v[1] + v[2] * v[2] + v[3] * v[3];
      }
      ss = wave_sum(ss);
      const float rinv = rsqrtf(ss * (1.f / 1024.f) + EPSF);
#pragma unroll
      for (int i = 0; i < 4; ++i) {
        const int k = i * 256 + lane * 4;
        const f32x4 hv = xv[rr][i] * rinv * Gv[i] * (scv[i] + 1.f) + shv[i];
        h[rr][i * 4 + 0] = hv[0]; h[rr][i * 4 + 1] = hv[1]; h[rr][i * 4 + 2] = hv[2]; h[rr][i * 4 + 3] = hv[3];
        u32x2 o; o[0] = pk_bf16(hv[0], hv[1]); o[1] = pk_bf16(hv[2], hv[3]);
        *(u32x2*)(h0 + (size_t)row * 1024 + k) = o;
      }
    }
    f32x2v hp[16];
#pragma unroll
    for (int k = 0; k < 16; ++k) hp[k] = (f32x2v){h[0][k], h[1][k]};
    float my0 = 0.f, my1 = 0.f;
#pragma unroll 2
    for (int j = 0; j < 16; ++j) {
      f32x2v ap = {0.f, 0.f};
#pragma unroll
      for (int i = 0; i < 4; ++i) {
        float4 w = *(const float4*)(wl + j * 1024 + i * 256 + lane * 4);
        ap += w.x * hp[i * 4] + w.y * hp[i * 4 + 1];
        ap += w.z * hp[i * 4 + 2] + w.w * hp[i * 4 + 3];
      }
      float a0 = wave_sum(ap[0]), a1 = wave_sum(ap[1]);
      if (lane == j) { my0 = a0; my1 = a1; }
    }
    if (lane < 16) {
#pragma unroll
      for (int rr = 0; rr < 2; ++rr) {
        const int row = it * 16 + wid * 2 + rr; float v = rr ? my1 : my0;
        if (lane < 8) bb[(size_t)row * 8 + lane] = sigm_f(v);
        else {
          int q = lane - 8; float z = v + p.dt_bias[q];
          float sp = z > 20.f ? z : log1pf(__expf(z));
          gb[(size_t)row * 8 + q] = -__expf(p.a_log[q]) * sp;
        }
      }
    }
  }

}

__device__ __forceinline__ int lds_byte(int r, int c) {
  int st = (r >> 4) * 2 + (c >> 5), ob = (r & 15) * 64 + (c & 31) * 2;
  return st * 1024 + (ob ^ (((ob >> 9) & 1) << 5));
}
__device__ __forceinline__ void stage_rc(int b, int& R, int& C) {
  int st = b >> 10, sb = b & 1023, swz = sb ^ (((sb >> 9) & 1) << 5);
  R = (st >> 1) * 16 + swz / 64;
  C = (st & 1) * 32 + (swz % 64) / 2;
}
constexpr int TILE_B = 256 * 64 * 2, STAGE_B = 2 * TILE_B;
#define WAIT_V0() asm volatile("s_waitcnt vmcnt(0)" ::: "memory")

template <int MT>
__device__ __forceinline__ void gemm_tile(f32x4 (&acc)[MT][4], const bf16_t* A, const u32 (&aoff)[4], const bf16_t* B, const u32 (&boff)[4], int nt, int tid) {
  const int wid = tid >> 6, lane = tid & 63, wr = wid >> 2, wc = wid & 3, fr = lane & 15, fq = lane >> 4;
#pragma unroll
  for (int m = 0; m < MT; ++m)
#pragma unroll
    for (int n = 0; n < 4; ++n) acc[m][n] = (f32x4){0.f, 0.f, 0.f, 0.f};
#define GSTAGE(buf, kt) do { _Pragma("unroll") for (int i = 0; i < 4; ++i) { \
    if (i < MT / 2) __builtin_amdgcn_global_load_lds((const u32*)(A + aoff[i] + (kt) * 64), (__attribute__((address_space(3))) u32*)(g_shm + (buf) * STAGE_B + wid * 1024 + i * 8192), 16, 0, 0); \
    __builtin_amdgcn_global_load_lds((const u32*)(B + boff[i] + (kt) * 64), (__attribute__((address_space(3))) u32*)(g_shm + (buf) * STAGE_B + TILE_B + wid * 1024 + i * 8192), 16, 0, 0); } } while (0)
  GSTAGE(0, 0); WAIT_V0(); __syncthreads();
  for (int t = 0; t < nt; ++t) {
    const int cur = t & 1;
    if (t + 1 < nt) GSTAGE(cur ^ 1, t + 1);
    const char* sa = g_shm + cur * STAGE_B; const char* sb = sa + TILE_B;
#pragma unroll
    for (int ks = 0; ks < 2; ++ks) {
      bf16x8 At[MT], Bf[4];
#pragma unroll
      for (int m = 0; m < MT; ++m) At[m] = *(const bf16x8*)(sa + lds_byte(wr * (MT * 16) + m * 16 + fr, ks * 32 + fq * 8));
#pragma unroll
      for (int n = 0; n < 4; ++n) Bf[n] = *(const bf16x8*)(sb + lds_byte(wc * 64 + n * 16 + fr, ks * 32 + fq * 8));
#pragma unroll
      for (int m = 0; m < MT; ++m)
#pragma unroll
        for (int n = 0; n < 4; ++n) acc[m][n] = __builtin_amdgcn_mfma_f32_16x16x32_bf16(Bf[n], At[m], acc[m][n], 0, 0, 0);
      __builtin_amdgcn_sched_barrier(0);
    }
    WAIT_V0(); __syncthreads();
  }
#undef GSTAGE
}


__device__ __forceinline__ void gemm_tile8p(f32x4 (&acc)[2][2][4][2], const bf16_t* A, size_t ahstep, const u32 (&voffA)[2], const bf16_t* B, size_t bhstep, const u32 (&voffB)[2], int nt, int tid) {
  const int wid = tid >> 6, lane = tid & 63, wr = wid >> 2, wc = wid & 3, fr = lane & 15, fq = lane >> 4;
#pragma unroll
  for (int ai = 0; ai < 2; ++ai)
#pragma unroll
    for (int bj = 0; bj < 2; ++bj)
#pragma unroll
      for (int m = 0; m < 4; ++m)
#pragma unroll
        for (int n = 0; n < 2; ++n) acc[ai][bj][m][n] = (f32x4){0.f, 0.f, 0.f, 0.f};
#define P8_SA(b, h) (g_shm + ((b) * 2 + (h)) * 16384)
#define P8_SB(b, h) (g_shm + (4 + (b) * 2 + (h)) * 16384)
#define P8_STA(b, h, kt) do { _Pragma("unroll") for (int _i = 0; _i < 2; ++_i) \
    __builtin_amdgcn_global_load_lds((const u32*)((const char*)(A + (h) * ahstep + (kt) * 64) + voffA[_i]), (__attribute__((address_space(3))) u32*)(P8_SA(b, h) + wid * 1024 + _i * 8192), 16, 0, 0); } while (0)
#define P8_STB(b, h, kt) do { _Pragma("unroll") for (int _i = 0; _i < 2; ++_i) \
    __builtin_amdgcn_global_load_lds((const u32*)((const char*)(B + (h) * bhstep + (kt) * 64) + voffB[_i]), (__attribute__((address_space(3))) u32*)(P8_SB(b, h) + wid * 1024 + _i * 8192), 16, 0, 0); } while (0)
#define P8_LDA(dst, b, h) do { _Pragma("unroll") for (int m = 0; m < 4; ++m) _Pragma("unroll") for (int k = 0; k < 2; ++k) \
    dst[m][k] = *(const bf16x8*)(P8_SA(b, h) + lds_byte(wr * 64 + m * 16 + fr, k * 32 + fq * 8)); } while (0)
#define P8_LDB(dst, b, h) do { _Pragma("unroll") for (int n = 0; n < 2; ++n) _Pragma("unroll") for (int k = 0; k < 2; ++k) \
    dst[n][k] = *(const bf16x8*)(P8_SB(b, h) + lds_byte(wc * 32 + n * 16 + fr, k * 32 + fq * 8)); } while (0)
#define P8_MMA(ai, bj, Af, Bfr) do { __builtin_amdgcn_s_setprio(1); \
    _Pragma("unroll") for (int m = 0; m < 4; ++m) _Pragma("unroll") for (int n = 0; n < 2; ++n) _Pragma("unroll") for (int k = 0; k < 2; ++k) \
      acc[ai][bj][m][n] = __builtin_amdgcn_mfma_f32_16x16x32_bf16(Bfr[n][k], Af[m][k], acc[ai][bj][m][n], 0, 0, 0); \
    __builtin_amdgcn_s_setprio(0); } while (0)
#define P8_WV(n) asm volatile("s_waitcnt vmcnt(" #n ")" ::: "memory")
#define P8_WL(n) asm volatile("s_waitcnt lgkmcnt(" #n ")" ::: "memory")
#define P8_BAR __builtin_amdgcn_s_barrier()
#define P8_SCHED __builtin_amdgcn_sched_barrier(0)
  bf16x8 At[4][2], B0[2][2], B1[2][2];
  __builtin_amdgcn_s_waitcnt(0x0F70);
  P8_STB(0, 0, 0); P8_STA(0, 0, 0); P8_STB(0, 1, 0); P8_STA(0, 1, 0);
  if (wr == 1) P8_BAR;
  P8_WV(4); P8_BAR;
  P8_STB(1, 0, 1); P8_STA(1, 0, 1); P8_STB(1, 1, 1);
  P8_WV(6); P8_BAR;
  for (int t = 0; t < nt - 2; t += 2) {
    P8_LDB(B0, 0, 0); P8_SCHED; P8_LDA(At, 0, 0); P8_STA(1, 1, t + 1);
    P8_WL(8); P8_BAR; P8_WL(0); P8_MMA(0, 0, At, B0); P8_BAR; P8_SCHED;
    P8_LDB(B1, 0, 1); P8_STB(0, 0, t + 2);
    P8_BAR; P8_WL(0); P8_MMA(0, 1, At, B1); P8_BAR;
    P8_LDA(At, 0, 1); P8_STA(0, 0, t + 2);
    P8_BAR; P8_WL(0); P8_MMA(1, 0, At, B0); P8_BAR; P8_SCHED;
    P8_STB(0, 1, t + 2);
    P8_WV(6); P8_BAR; P8_MMA(1, 1, At, B1); P8_BAR;
    P8_LDB(B0, 1, 0); P8_SCHED; P8_LDA(At, 1, 0); P8_STA(0, 1, t + 2);
    P8_WL(8); P8_BAR; P8_WL(0); P8_MMA(0, 0, At, B0); P8_BAR; P8_SCHED;
    P8_LDB(B1, 1, 1); P8_STB(1, 0, t + 3);
    P8_BAR; P8_WL(0); P8_MMA(0, 1, At, B1); P8_BAR;
    P8_LDA(At, 1, 1); P8_STA(1, 0, t + 3);
    P8_BAR; P8_WL(0); P8_MMA(1, 0, At, B0); P8_BAR; P8_SCHED;
    P8_STB(1, 1, t + 3);
    P8_WV(6); P8_BAR; P8_MMA(1, 1, At, B1); P8_BAR;
  }
  { P8_LDB(B0, 0, 0); P8_LDA(At, 0, 0); P8_STA(1, 1, nt - 1);
    P8_BAR; P8_WL(0); P8_MMA(0, 0, At, B0); P8_BAR;
    P8_LDB(B1, 0, 1); P8_BAR; P8_WL(0); P8_MMA(0, 1, At, B1); P8_BAR;
    P8_LDA(At, 0, 1); P8_WV(4); P8_BAR; P8_WL(0); P8_MMA(1, 0, At, B0); P8_MMA(1, 1, At, B1); P8_BAR; }
  { P8_LDB(B0, 1, 0); P8_LDA(At, 1, 0); P8_WV(2); P8_BAR; P8_WL(0); P8_MMA(0, 0, At, B0); P8_BAR;
    P8_LDB(B1, 1, 1); P8_WV(0); P8_BAR; P8_WL(0); P8_MMA(0, 1, At, B1); P8_BAR;
    P8_LDA(At, 1, 1); P8_BAR; P8_WL(0); P8_MMA(1, 0, At, B0); P8_MMA(1, 1, At, B1); P8_BAR; }
  if (wr == 0) P8_BAR;
  __syncthreads();
}

__device__ __forceinline__ void tile_map(int v, int nM, int nN, int& pm, int& pn) {
  int nig = 8 * nN, gid = v / nig, fm = gid * 8, gsz = min(nM - fm, 8);
  pm = fm + (v % nig) % gsz; pn = (v % nig) / gsz;
}
__device__ __forceinline__ int block_lin(const P& p) {
  const int b = BIDX(), G = GRIDX();
  return (b & 7) * (G >> 3) + (b >> 3);
}

struct MTile { int base, L, ts, lo, hi; };
__device__ __forceinline__ MTile mtile_conv(int mt) {
  MTile t;
  if (mt < 32) { t.base = mt * 256; t.L = 256; t.ts = 0; t.lo = 0; t.hi = 256; }
  else { int lt = mt - 32, s = lt / 17, j = lt % 17; t.base = NCTX + s * 4096; t.L = 4096; t.ts = 254 * j - 1; t.lo = 1; t.hi = min(255, 4096 - t.ts); }
  return t;
}
__device__ __forceinline__ int mt_grow(const MTile& t, int lr) { return t.base + min(max(t.ts + lr, 0), t.L - 1); }
__device__ __forceinline__ bool mt_valid(const MTile& t, int lr) { int q = t.ts + lr; return lr >= 0 && lr < 256 && q >= 0 && q < t.L; }

__device__ __forceinline__ void ct_load8(int lr, int colbyte, float (&o)[8]) { unpack8(*(const u32x4*)(g_shm + lr * 544 + colbyte), o); }
__device__ __forceinline__ void ct_load8z(const MTile& t, int lr, int colbyte, float (&o)[8]) {
  if (mt_valid(t, lr)) ct_load8(lr, colbyte, o);
  else {
#pragma unroll
    for (int e = 0; e < 8; ++e) o[e] = 0.f;
  }
}

__device__ __forceinline__ void gemm_inproj(const P& p) {
  const bf16_t* A = (const bf16_t*)(p.ws + OFF_R1); const bf16_t* B = (const bf16_t*)(p.ws + OFF_WIN);
  bf16_t* Q = (bf16_t*)(p.ws + OFF_Q); bf16_t* K = (bf16_t*)(p.ws + OFF_K); bf16_t* V = (bf16_t*)(p.ws + OFF_V);
  bf16_t* GS = (bf16_t*)(p.ws + OFF_GS); bf16_t* CAT = (bf16_t*)(p.ws + OFF_CAT);
  const int nM = 100, nN = 14, G = GRIDX(), lin = block_lin(p);
  for (int v = lin; v < nM * nN; v += G) {
    const int tid = opaque_tid();
    int sR[4], sC[4];
    { const int wid = tid >> 6, lane = tid & 63;
#pragma unroll
      for (int i = 0; i < 4; ++i) stage_rc(wid * 1024 + i * 8192 + lane * 16, sR[i], sC[i]); }
    int pm, pn; tile_map(v, nM, nN, pm, pn);
    const MTile mt = mtile_conv(pm);
    u32 voffA[2], voffB[2];
#pragma unroll
    for (int i = 0; i < 2; ++i) { voffA[i] = (u32)(sR[i] * 1024 + sC[i]) * 2u; voffB[i] = voffA[i]; }
    f32x4 acc[2][2][4][2];
    gemm_tile8p(acc, A + (long)(mt.base + mt.ts) * 1024, (size_t)128 * 1024, voffA, B + (size_t)pn * 256 * 1024, (size_t)128 * 1024, voffB, 16, tid);
    asm volatile("" ::: "memory");
    const int tide = opaque_tid();
    const int wid = tide >> 6, lane = tide & 63, wr = wid >> 2, wc = wid & 3, fr = lane & 15, fq = lane >> 4; (void)wid; (void)lane;
#pragma unroll
    for (int ai = 0; ai < 2; ++ai)
#pragma unroll
      for (int bj = 0; bj < 2; ++bj)
#pragma unroll
        for (int m = 0; m < 4; ++m)
#pragma unroll
          for (int n = 0; n < 2; ++n) {
            const f32x4 a = acc[ai][bj][m][n];
            u32x2 o; o[0] = pk_bf16(a[0], a[1]); o[1] = pk_bf16(a[2], a[3]);
            *(u32x2*)(g_shm + (ai * 128 + wr * 64 + m * 16 + fr) * 544 + (bj * 128 + wc * 32 + n * 16 + fq * 4) * 2) = o;
          }
    __syncthreads();
    if (pn < 6) {
      const int cc = tide & 31, rg = tide >> 5, lr0 = rg * 16;
      float w0[8], w1[8], w2[8];
#pragma unroll
      for (int e = 0; e < 8; ++e) { int col = pn * 256 + cc * 8 + e; w0[e] = p.conv_qkv[col]; w1[e] = p.conv_qkv[1536 + col]; w2[e] = p.conv_qkv[3072 + col]; }
      bf16_t* dst = pn < 2 ? Q : pn < 4 ? K : V;
      const int dcol = (pn & 1) * 256 + cc * 8;
      const float post = pn < 2 ? 0.08838834764831845f : 1.f;
      float prev[8], cur[8], nxt[8];
      ct_load8z(mt, lr0 - 1, cc * 16, prev); ct_load8z(mt, lr0, cc * 16, cur);
#pragma unroll 4
      for (int i = 0; i < 16; ++i) {
        const int lr = lr0 + i;
        ct_load8z(mt, lr + 1, cc * 16, nxt);
        float o[8]; float ss = 0.f;
#pragma unroll
        for (int e = 0; e < 8; ++e) { float u = w0[e] * prev[e] + w1[e] * cur[e] + w2[e] * nxt[e]; o[e] = silu_f(u); ss += o[e] * o[e]; }
        if (pn < 4) {
          ss = sum16(ss);
          const float sc = rsqrtf(ss + EPSF) * post;
#pragma unroll
          for (int e = 0; e < 8; ++e) o[e] *= sc;
        }
        if (lr >= mt.lo && lr < mt.hi) *(u32x4*)(dst + (size_t)mt_grow(mt, lr) * 512 + dcol) = pack8(o);
#pragma unroll
        for (int e = 0; e < 8; ++e) { prev[e] = cur[e]; cur[e] = nxt[e]; }
      }
    } else {
      const int mm = pn - 6, cc = tide & 7, rg = tide >> 3, lr0 = rg * 4;
      float w0[8], w1[8], w2[8];
#pragma unroll
      for (int e = 0; e < 8; ++e) { int col = mm * 64 + cc * 8 + e; w0[e] = p.conv_b[col]; w1[e] = p.conv_b[512 + col]; w2[e] = p.conv_b[1024 + col]; }
      float prev[8], cur[8], nxt[8], t1[8], t2[8];
      ct_load8z(mt, lr0 - 1, 128 + cc * 16, t1); ct_load8z(mt, lr0 - 1, 256 + cc * 16, t2);
#pragma unroll
      for (int e = 0; e < 8; ++e) prev[e] = t1[e] * t2[e];
      ct_load8z(mt, lr0, 128 + cc * 16, t1); ct_load8z(mt, lr0, 256 + cc * 16, t2);
#pragma unroll
      for (int e = 0; e < 8; ++e) cur[e] = t1[e] * t2[e];
#pragma unroll
      for (int i = 0; i < 4; ++i) {
        const int lr = lr0 + i;
        ct_load8z(mt, lr + 1, 128 + cc * 16, t1); ct_load8z(mt, lr + 1, 256 + cc * 16, t2);
#pragma unroll
        for (int e = 0; e < 8; ++e) nxt[e] = t1[e] * t2[e];
        if (lr >= mt.lo && lr < mt.hi) {
          float bg[8], gt[8], o[8], o2[8];
          ct_load8(lr, cc * 16, bg); ct_load8(lr, 384 + cc * 16, gt);
#pragma unroll
          for (int e = 0; e < 8; ++e) { o[e] = bg[e] * (w0[e] * prev[e] + w1[e] * cur[e] + w2[e] * nxt[e]); o2[e] = silu_f(gt[e]); }
          const size_t grow = (size_t)mt_grow(mt, lr);
          *(u32x4*)(CAT + grow * 1024 + 512 + mm * 64 + cc * 8) = pack8(o);
          *(u32x4*)(GS + grow * 512 + mm * 64 + cc * 8) = pack8(o2);
        }
#pragma unroll
        for (int e = 0; e < 8; ++e) { prev[e] = cur[e]; cur[e] = nxt[e]; }
      }
    }
    __syncthreads();
  }
}

__device__ __forceinline__ void gemm_ffn_gu(const P& p, int layer, const bf16_t* A) {
  const bf16_t* B = (const bf16_t*)(p.ws + OFF_WGU) + (size_t)layer * 5632 * 1024;
  bf16_t* ACT = (bf16_t*)(p.ws + OFF_ACT);
  const float* rsq = (const float*)(p.ws + OFF_RSQ);
  const float* sW = (const float*)(p.ws + OFF_SW);
  const float* cw = p.ffn_conv + (size_t)layer * 3 * 2816;
  const int nM = 100, nN = 22, G = GRIDX(), lin = block_lin(p);
  for (int v = lin; v < nM * nN; v += G) {
    const int tid = opaque_tid();
    int sR[4], sC[4];
    { const int wid = tid >> 6, lane = tid & 63;
#pragma unroll
      for (int i = 0; i < 4; ++i) stage_rc(wid * 1024 + i * 8192 + lane * 16, sR[i], sC[i]); }
    int pm, pn; tile_map(v, nM, nN, pm, pn);
    const MTile mt = mtile_conv(pm);
    u32 voffA[2], voffB[2];
#pragma unroll
    for (int i = 0; i < 2; ++i) { voffA[i] = (u32)(sR[i] * 1024 + sC[i]) * 2u; voffB[i] = voffA[i]; }
    f32x4 acc[2][2][4][2];
    gemm_tile8p(acc, A + (long)(mt.base + mt.ts) * 1024, (size_t)128 * 1024, voffA, B + (size_t)pn * 256 * 1024, (size_t)128 * 1024, voffB, 16, tid);
    asm volatile("" ::: "memory");
    const int tide = opaque_tid();
    const int wid = tide >> 6, lane = tide & 63, wr = wid >> 2, wc = wid & 3, fr = lane & 15, fq = lane >> 4; (void)wid; (void)lane;
    const int cond = row_cond(mt.base);
    const float* sWc = sW + ((size_t)layer * 5 + cond) * 5632 + pn * 256 + wc * 32 + fq * 4;
    f32x4 s4[2][2];
#pragma unroll
    for (int bj = 0; bj < 2; ++bj)
#pragma unroll
      for (int n = 0; n < 2; ++n) s4[bj][n] = *(const f32x4*)(sWc + bj * 128 + n * 16);
#pragma unroll
    for (int ai = 0; ai < 2; ++ai)
#pragma unroll
      for (int m = 0; m < 4; ++m) {
        const int lr = ai * 128 + wr * 64 + m * 16 + fr, g = mt_grow(mt, lr);
        const float rinv = rsqrtf((rsq[g] + rsq[NTOK + g] + rsq[2 * NTOK + g] + rsq[3 * NTOK + g]) * (1.f / 1024.f) + EPSF);
#pragma unroll
        for (int bj = 0; bj < 2; ++bj)
#pragma unroll
          for (int n = 0; n < 2; ++n) {
            f32x4 t = acc[ai][bj][m][n] * rinv + s4[bj][n];
            u32x2 o; o[0] = pk_bf16(t[0], t[1]); o[1] = pk_bf16(t[2], t[3]);
            *(u32x2*)(g_shm + lr * 544 + (bj * 128 + wc * 32 + n * 16 + fq * 4) * 2) = o;
          }
        asm volatile("" ::: "memory");
      }
    __syncthreads();
    {
      const int cc = tide & 15, rg = tide >> 4, lr0 = rg * 8;
      float w0[8], w1[8], w2[8];
#pragma unroll
      for (int e = 0; e < 8; ++e) { int col = pn * 128 + cc * 8 + e; w0[e] = cw[col]; w1[e] = cw[2816 + col]; w2[e] = cw[2 * 2816 + col]; }
      float prev[8], cur[8], nxt[8];
      ct_load8z(mt, lr0 - 1, cc * 16, prev); ct_load8z(mt, lr0, cc * 16, cur);
#pragma unroll 4
      for (int i = 0; i < 8; ++i) {
        const int lr = lr0 + i;
        ct_load8z(mt, lr + 1, cc * 16, nxt);
        if (lr >= mt.lo && lr < mt.hi) {
          float up[8], o[8];
          ct_load8(lr, 256 + cc * 16, up);
#pragma unroll
          for (int e = 0; e < 8; ++e) { float u = w0[e] * prev[e] + w1[e] * cur[e] + w2[e] * nxt[e]; o[e] = silu_f(u) * up[e]; }
          *(u32x4*)(ACT + (size_t)mt_grow(mt, lr) * 2816 + pn * 128 + cc * 8) = pack8(o);
        }
#pragma unroll
        for (int e = 0; e < 8; ++e) { prev[e] = cur[e]; cur[e] = nxt[e]; }
      }
    }
    __syncthreads();
  }
}

__device__ __forceinline__ void gemm_resid(const P& p, int mode, int layer, const bf16_t* A, int lda, const bf16_t* Bw, int ldb, int nk, bf16_t* A2) {
  const float* mod = (const float*)(p.ws + OFF_MOD);
  float* rsq = (float*)(p.ws + OFF_RSQ);
  const bf16_t* X = (const bf16_t*)p.out;
  bf16_t* Xout = (mode == 1 && layer == 1) ? (bf16_t*)(p.ws + OFF_R1) : (bf16_t*)p.out;
  const int nM = 96, nN = 4, G = GRIDX(), lin = block_lin(p);
  const int ntiles = nM * nN, nfull = (ntiles / G) * G, nrem = ntiles - nfull;
  const bool split = nrem > 0 && 2 * nrem <= G;
  auto epi_rows = [&](int pn, size_t growbase, const float* mc, int wid, int lane) {
    const int ccol = pn * 256 + lane * 4;
    const f32x4 gvn = *(const f32x4*)(mc + (mode == 1 ? 5 : 2) * 1024 + ccol);
    f32x4 gsn = gvn, csn = gvn;
    if (mode != 1) { f32x4 ng = *(const f32x4*)(p.norm_ffn_g + layer * 1024 + ccol), sc = *(const f32x4*)(mc + 4 * 1024 + ccol); gsn = ng * (sc + 1.f); }
    if (mode == 2) csn = *(const f32x4*)(p.pool_scale + ccol);
    u32x2 xrow[16];
#pragma unroll
    for (int r = 0; r < 16; ++r) xrow[r] = *(const u32x2*)(X + (growbase + wid * 16 + r) * 1024 + ccol);
#pragma unroll
    for (int r = 0; r < 16; ++r) {
      const int lrow = wid * 16 + r; const size_t grow = growbase + lrow;
      f32x4 y = *(const f32x4*)(g_shm + lrow * 1088 + lane * 16);
      if (mode == 2) y = y * csn;
      const u32x2 xr = xrow[r];
      f32x4 x = (f32x4){bf_lo(xr[0]), bf_hi(xr[0]), bf_lo(xr[1]), bf_hi(xr[1])};
      x = x + gvn * y;
      { u32x2 xo; xo[0] = pk_bf16(x[0], x[1]); xo[1] = pk_bf16(x[2], x[3]); *(u32x2*)(Xout + grow * 1024 + ccol) = xo; }
      if (mode != 1) { f32x4 a = x * gsn; u32x2 o; o[0] = pk_bf16(a[0], a[1]); o[1] = pk_bf16(a[2], a[3]); *(u32x2*)(A2 + grow * 1024 + ccol) = o; }
      const float ss = wave_sum(x[0] * x[0] + x[1] * x[1] + x[2] * x[2] + x[3] * x[3]);
      if (lane == 0) rsq[(size_t)pn * NTOK + grow] = ss;
    }
  };
  for (int v = lin;; v += G) {
    const int tid = opaque_tid();
    int sR[4], sC[4];
    { const int wid = tid >> 6, lane = tid & 63;
#pragma unroll
      for (int i = 0; i < 4; ++i) stage_rc(wid * 1024 + i * 8192 + lane * 16, sR[i], sC[i]); }
    int tile, mh = -1;
    if (!split || v < nfull) { if (v >= ntiles) break; tile = v; }
    else { const int u = v - nfull; if (u >= 2 * nrem) break; tile = nfull + (u >> 1); mh = u & 1; }
    int pm, pn; tile_map(tile, nM, nN, pm, pn);
    const float* mc = mod + ((size_t)layer * 5 + row_cond(pm * 256)) * 6144;
    if (mh < 0) {
      u32 voffA[2], voffB[2];
#pragma unroll
      for (int i = 0; i < 2; ++i) { voffA[i] = (u32)(sR[i] * lda + sC[i]) * 2u; voffB[i] = (u32)(sR[i] * ldb + sC[i]) * 2u; }
      f32x4 acc[2][2][4][2];
      gemm_tile8p(acc, A + (size_t)pm * 256 * lda + (mode == 2 ? pn * 256 : 0), (size_t)128 * lda, voffA,
                  Bw + (mode == 2 ? (size_t)pn * 65536 : (size_t)pn * 256 * ldb), (size_t)128 * ldb, voffB, nk, tid);
      asm volatile("" ::: "memory");
    const int tide = opaque_tid();
    const int wid = tide >> 6, lane = tide & 63, wr = wid >> 2, wc = wid & 3, fr = lane & 15, fq = lane >> 4; (void)wid; (void)lane;
#pragma unroll
      for (int hf = 0; hf < 2; ++hf) {
#pragma unroll
        for (int bj = 0; bj < 2; ++bj)
#pragma unroll
          for (int m = 0; m < 4; ++m)
#pragma unroll
            for (int n = 0; n < 2; ++n) *(f32x4*)(g_shm + (wr * 64 + m * 16 + fr) * 1088 + (bj * 128 + wc * 32 + n * 16 + fq * 4) * 4) = acc[hf][bj][m][n];
        __syncthreads();
        epi_rows(pn, (size_t)pm * 256 + hf * 128, mc, wid, lane);
        __syncthreads();
      }
    } else {
      u32 aoff[4], boff[4];
#pragma unroll
      for (int i = 0; i < 4; ++i) {
        aoff[i] = (u32)(pm * 256 + (mh > 0 ? 128 : 0) + sR[i]) * (u32)lda + sC[i] + (mode == 2 ? pn * 256 : 0);
        boff[i] = (mode == 2 ? (u32)pn * 65536u + (u32)sR[i] * 256u : (u32)(pn * 256 + sR[i]) * (u32)ldb) + sC[i];
      }
      f32x4 acc[4][4];
      gemm_tile<4>(acc, A, aoff, Bw, boff, nk, tid);
      asm volatile("" ::: "memory");
    const int tide = opaque_tid();
    const int wid = tide >> 6, lane = tide & 63, wr = wid >> 2, wc = wid & 3, fr = lane & 15, fq = lane >> 4; (void)wid; (void)lane;
#pragma unroll
      for (int m = 0; m < 4; ++m)
#pragma unroll
        for (int n = 0; n < 4; ++n) *(f32x4*)(g_shm + (wr * 64 + m * 16 + fr) * 1088 + (wc * 64 + n * 16 + fq * 4) * 4) = acc[m][n];
      __syncthreads();
      epi_rows(pn, (size_t)pm * 256 + mh * 128, mc, wid, lane);
      __syncthreads();
    }
  }
}

template <bool REV>
__device__ __forceinline__ void tri_solve(const float* Mp, float* Tl, int lane, bf16_t* Tg) {
  auto Mrow4 = [&](int i, int j) -> f32x4 {
    if (REV) { const f32x4 v = *(const f32x4*)(Mp + (63 - i) * 64 + 60 - j); return (f32x4){v[3], v[2], v[1], v[0]}; }
    return *(const f32x4*)(Mp + i * 64 + j);
  };
  auto M1 = [&](int i, int j) -> float { return REV ? Mp[(63 - i) * 64 + (63 - j)] : Mp[i * 64 + j]; };
  for (int g = 0; g < 16; ++g) {
    const int i0 = 4 * g;
    float a0 = (i0 == lane) ? 1.f : 0.f, a1 = (i0 + 1 == lane) ? 1.f : 0.f, a2 = (i0 + 2 == lane) ? 1.f : 0.f, a3 = (i0 + 3 == lane) ? 1.f : 0.f;
#pragma unroll 2
    for (int j = 0; j < i0; j += 4) {
      const float t0 = Tl[j * 64 + lane], t1 = Tl[(j + 1) * 64 + lane], t2 = Tl[(j + 2) * 64 + lane], t3 = Tl[(j + 3) * 64 + lane];
      const f32x4 m0 = Mrow4(i0, j), m1 = Mrow4(i0 + 1, j), m2 = Mrow4(i0 + 2, j), m3 = Mrow4(i0 + 3, j);
      a0 -= (m0[0] * t0 + m0[1] * t1) + (m0[2] * t2 + m0[3] * t3);
      a1 -= (m1[0] * t0 + m1[1] * t1) + (m1[2] * t2 + m1[3] * t3);
      a2 -= (m2[0] * t0 + m2[1] * t1) + (m2[2] * t2 + m2[3] * t3);
      a3 -= (m3[0] * t0 + m3[1] * t1) + (m3[2] * t2 + m3[3] * t3);
    }
    const float T0 = a0;
    const float T1 = a1 - M1(i0 + 1, i0) * T0;
    const float T2 = a2 - (M1(i0 + 2, i0) * T0 + M1(i0 + 2, i0 + 1) * T1);
    const float T3 = a3 - (M1(i0 + 3, i0) * T0 + M1(i0 + 3, i0 + 1) * T1 + M1(i0 + 3, i0 + 2) * T2);
    Tl[i0 * 64 + lane] = T0; Tl[(i0 + 1) * 64 + lane] = T1; Tl[(i0 + 2) * 64 + lane] = T2; Tl[(i0 + 3) * 64 + lane] = T3;
    const float tv[4] = {T0, T1, T2, T3};
#pragma unroll
    for (int r = 0; r < 4; ++r) {
      const int i = i0 + r;
      const bf16_t v = (bf16_t)(pk_bf16(tv[r], 0.f) & 0xffffu);
      if (REV) { if (i > lane) Tg[(63 - i) * 64 + (63 - lane)] = v; }
      else { if (i >= lane) Tg[i * 64 + lane] = v; }
    }
  }
}

__device__ __forceinline__ void phase3(const P& p) {
  const int tid = opaque_tid(), sub = tid >> 8, t = tid & 255, w = t >> 6, lane = tid & 63, fr = lane & 15, fq = lane >> 4;
  char* sm = g_shm + sub * 69632;
  char* sk = sm;
  char* sq = sm + 17408;
  float* KK = (float*)(sm + 34816);
  float* QK = (float*)(sm + 51200);
  float* sc = (float*)(sm + 67584);
  const bf16_t* Q = (const bf16_t*)(p.ws + OFF_Q); const bf16_t* K = (const bf16_t*)(p.ws + OFF_K);
  const float* gb = (const float*)(p.ws + OFF_G); const float* bb = (const float*)(p.ws + OFF_BETA);
  bf16_t* Tp = (bf16_t*)(p.ws + OFF_TP); bf16_t* Ap = (bf16_t*)(p.ws + OFF_AP);
  u32x4 pk[4], pq[4];
  auto issue = [&](int it_) {
    const int item_ = it_ * 2 + sub, row0_ = (item_ >> 2) * 64, h_ = item_ & 3;
#pragma unroll
    for (int i = 0; i < 4; ++i) {
      int idx = t + 256 * i, r = idx >> 4, cc = idx & 15;
      pk[i] = *(const u32x4*)(K + (size_t)(row0_ + r) * 512 + h_ * 128 + cc * 8);
      pq[i] = *(const u32x4*)(Q + (size_t)(row0_ + r) * 512 + h_ * 128 + cc * 8);
    }
  };
  if (BIDX() < 768) issue(BIDX());
  for (int it = BIDX(); it < 768; it += GRIDX()) {
    const int item = it * 2 + sub, ch = item >> 2, h = item & 3, row0 = ch * 64;
#pragma unroll
    for (int i = 0; i < 4; ++i) {
      int idx = t + 256 * i, r = idx >> 4, cc = idx & 15;
      *(u32x4*)(sk + r * 272 + cc * 16) = pk[i];
      *(u32x4*)(sq + r * 272 + cc * 16) = pq[i];
    }
    if (t < 64) {
      float g = gb[(size_t)(row0 + t) * 8 + h];
g = wave_prefix(g, lane);
      sc[t] = g; sc[128 + t] = bb[(size_t)(row0 + t) * 8 + h];
    } else if (t < 128) {
      const int i = 63 - lane;
      float g = gb[(size_t)(row0 + i) * 8 + 4 + h];
g = wave_prefix(g, lane);
      sc[64 + i] = g; sc[192 + i] = bb[(size_t)(row0 + i) * 8 + 4 + h];
    }
    __syncthreads();
    {
      f32x4 a1[4], a2[4];
#pragma unroll
      for (int n = 0; n < 4; ++n) { a1[n] = (f32x4){0.f, 0.f, 0.f, 0.f}; a2[n] = a1[n]; }
#pragma unroll
      for (int ks = 0; ks < 4; ++ks) {
        bf16x8 ak = *(const bf16x8*)(sk + (16 * w + fr) * 272 + (ks * 32 + fq * 8) * 2);
        bf16x8 aq = *(const bf16x8*)(sq + (16 * w + fr) * 272 + (ks * 32 + fq * 8) * 2);
#pragma unroll
        for (int n = 0; n < 4; ++n) {
          bf16x8 b = *(const bf16x8*)(sk + (16 * n + fr) * 272 + (ks * 32 + fq * 8) * 2);
          a1[n] = __builtin_amdgcn_mfma_f32_16x16x32_bf16(ak, b, a1[n], 0, 0, 0);
          a2[n] = __builtin_amdgcn_mfma_f32_16x16x32_bf16(aq, b, a2[n], 0, 0, 0);
        }
      }
#pragma unroll
      for (int n = 0; n < 4; ++n)
#pragma unroll
        for (int j = 0; j < 4; ++j) {
          const int c = 16 * w + fq * 4 + j, s = 16 * n + fr;
          float mval, aval;
          if (s < c) { float d = __expf(sc[c] - sc[s]); mval = sc[128 + c] * a1[n][j] * d; aval = a2[n][j] * d; }
          else if (s > c) { float d = __expf(sc[64 + c] - sc[64 + s]); mval = sc[192 + c] * a1[n][j] * d; aval = a2[n][j] * d; }
          else { mval = 0.f; aval = a2[n][j]; }
          KK[c * 64 + s] = mval; QK[c * 64 + s] = aval;
        }
    }
    __syncthreads();
    if (it + GRIDX() < 768) issue(it + GRIDX());
    const int role = sub ? (w ^ 2) : w;
    if (role == 0) tri_solve<false>(KK, (float*)sk, lane, Tp + (size_t)item * 4096);
    else if (role == 1) tri_solve<true>(KK, (float*)sk + 4096, lane, Tp + (size_t)item * 4096);
    else {
      const int u = sub ? t : t - 128;
#pragma unroll
      for (int i = 0; i < 4; ++i) {
        int idx = u + 128 * i; float o[8];
#pragma unroll
        for (int e = 0; e < 8; ++e) o[e] = QK[idx * 8 + e];
        *(u32x4*)(Ap + (size_t)item * 4096 + idx * 8) = pack8(o);
      }
    }
    __syncthreads();
  }
}

constexpr int S_KT = 0, S_VT = 36864, S_ST = 46080, S_RT = 54784, S_VN = 59392, S_VNS = 64000, S_OT = 68608, S_SC = 78848;
constexpr int D_KT = 18432, D_VT = 4608, D_OT = 5120, D_SC = 1024;

__device__ __forceinline__ u32x4 mask_frag(u32x4 v, int r, int c0, int dir, bool unit_diag) {
#pragma unroll
  for (int e = 0; e < 4; ++e) {
    const int ca = c0 + 2 * e, cb = ca + 1;
    u32 lo = v[e] & 0xffffu, hi = v[e] >> 16;
    const bool ka = dir ? (ca > r) : (ca < r), kb = dir ? (cb > r) : (cb < r);
    if (!ka) lo = (ca == r) ? (unit_diag ? 0x3f80u : lo) : 0u;
    if (!kb) hi = (cb == r) ? (unit_diag ? 0x3f80u : hi) : 0u;
    v[e] = lo | (hi << 16);
  }
  return v;
}

__device__ __forceinline__ void scan_item(const P& p, int item) {
  const int tid = opaque_tid(), w = tid >> 6, lane = tid & 63, fr = lane & 15, fq = lane >> 4;
  int seqbase, nchunk, sidx, rem; bool lat;
  if (item < 128) { lat = true; sidx = item >> 5; rem = item & 31; seqbase = NCTX + sidx * 4096; nchunk = 64; }
  else { lat = false; const int u = item - 128; sidx = u >> 5; rem = u & 31; seqbase = sidx * 256; nchunk = 4; }
  const int h = rem >> 3, dir = (rem >> 2) & 1, q4 = rem & 3, dvoff = h * 128 + q4 * 32;
  const bf16_t* Q = (const bf16_t*)(p.ws + OFF_Q); const bf16_t* K = (const bf16_t*)(p.ws + OFF_K); const bf16_t* V = (const bf16_t*)(p.ws + OFF_V);
  const float* gb = (const float*)(p.ws + OFF_G); const float* bb = (const float*)(p.ws + OFF_BETA);
  const bf16_t* Tp = (const bf16_t*)(p.ws + OFF_TP); const bf16_t* Ap = (const bf16_t*)(p.ws + OFF_AP);
  bf16_t* obuf = dir == 0 ? (bf16_t*)(p.ws + OFF_CAT) : (bf16_t*)(p.ws + OFF_OB);
  const int old_ = dir == 0 ? 1024 : 512;
  f32x4 S[2];
  if (lat) {
    const float* s0 = p.state + (((size_t)sidx * 2 + dir) * 4 + h) * 16384;
#pragma unroll
    for (int n = 0; n < 2; ++n)
#pragma unroll
      for (int j = 0; j < 4; ++j) S[n][j] = s0[(16 * w + fq * 4 + j) * 128 + q4 * 32 + n * 16 + fr];
  } else {
#pragma unroll
    for (int n = 0; n < 2; ++n) S[n] = (f32x4){0.f, 0.f, 0.f, 0.f};
  }
#pragma unroll
  for (int n = 0; n < 2; ++n) {
    u32x2 o; o[0] = pk_bf16(S[n][0], S[n][1]); o[1] = pk_bf16(S[n][2], S[n][3]);
    *(u32x2*)(g_shm + S_ST + (n * 16 + fr) * 272 + (16 * w + fq * 4) * 2) = o;
  }
  u32x4 na[4], nt[2], nat[2];
  u32x4 pk[2], pv;
  float pg = 0.f, pb = 0.f;
  const int arow = 16 * (w & 3) + fr;
  auto issue_loads = [&](int cidx) {
    const int row0 = seqbase + cidx * 64; const size_t pit = ((size_t)(row0 >> 6) * 4 + h) * 4096;
    const bf16_t* ab = (w < 4 ? K : Q) + (size_t)(row0 + arow) * 512 + h * 128 + fq * 8;
#pragma unroll
    for (int ks = 0; ks < 4; ++ks) na[ks] = *(const u32x4*)(ab + ks * 32);
#pragma unroll
    for (int ks = 0; ks < 2; ++ks) { nt[ks] = *(const u32x4*)(Tp + pit + arow * 64 + ks * 32 + fq * 8); nat[ks] = *(const u32x4*)(Ap + pit + arow * 64 + ks * 32 + fq * 8); }
#pragma unroll
    for (int i = 0; i < 2; ++i) pk[i] = *(const u32x4*)(K + (size_t)(row0 + lane) * 512 + h * 128 + (w + 8 * i) * 8);
    pv = *(const u32x4*)(V + (size_t)(row0 + lane) * 512 + dvoff + (w & 3) * 8);
    if (tid < 64) { int i = dir ? 63 - lane : lane; pg = gb[(size_t)(row0 + i) * 8 + dir * 4 + h]; pb = bb[(size_t)(row0 + i) * 8 + dir * 4 + h]; }
  };
  auto store_tiles = [&](int buf) {
    float* scl = (float*)(g_shm + S_SC + buf * D_SC);
#pragma unroll
    for (int i = 0; i < 2; ++i) {
      const int cc = w + 8 * i;
#pragma unroll
      for (int e = 0; e < 4; ++e) {
        *(bf16_t*)(g_shm + S_KT + buf * D_KT + (cc * 8 + 2 * e) * 144 + lane * 2) = (bf16_t)(pk[i][e] & 0xffffu);
        *(bf16_t*)(g_shm + S_KT + buf * D_KT + (cc * 8 + 2 * e + 1) * 144 + lane * 2) = (bf16_t)(pk[i][e] >> 16);
      }
    }
    if (w < 4) {
#pragma unroll
      for (int e = 0; e < 4; ++e) {
        *(bf16_t*)(g_shm + S_VT + buf * D_VT + (w * 8 + 2 * e) * 144 + lane * 2) = (bf16_t)(pv[e] & 0xffffu);
        *(bf16_t*)(g_shm + S_VT + buf * D_VT + (w * 8 + 2 * e + 1) * 144 + lane * 2) = (bf16_t)(pv[e] >> 16);
      }
    }
    if (tid < 64) {
      float g = wave_prefix(pg, lane);
      const float tot = rdlane(g, 63);
      const int i = dir ? 63 - lane : lane;
      scl[i] = __expf(g); scl[64 + i] = __expf(tot - g); scl[128 + i] = pb;
      if (lane == 0) scl[192] = __expf(tot);
    }
  };
  u32 tch = 0;
  auto touch = [&](int cidx_t) {
    const int r0 = seqbase + cidx_t * 64; const size_t pit = ((size_t)(r0 >> 6) * 4 + h) * 4096;
    const bf16_t* a;
    if (tid < 128) a = K + (size_t)(r0 + (tid >> 1)) * 512 + h * 128 + (tid & 1) * 64;
    else if (tid < 256) a = Q + (size_t)(r0 + ((tid - 128) >> 1)) * 512 + h * 128 + (tid & 1) * 64;
    else if (tid < 320) a = Tp + pit + (tid - 256) * 64;
    else if (tid < 384) a = Ap + pit + (tid - 320) * 64;
    else if (tid < 448) a = V + (size_t)(r0 + (tid - 384)) * 512 + dvoff;
    else if (tid < 464) a = (const bf16_t*)(gb + (size_t)(r0 + (tid - 448) * 4) * 8);
    else if (tid < 480) a = (const bf16_t*)(bb + (size_t)(r0 + (tid - 464) * 4) * 8);
    else a = K + (size_t)r0 * 512 + h * 128;
    tch = *(const u32*)a;
  };
  issue_loads(dir ? nchunk - 1 : 0);
  store_tiles(0);
  __syncthreads();
  for (int st = 0; st < nchunk; ++st) {
    const int cidx = dir ? nchunk - 1 - st : st;
    const int row0 = seqbase + cidx * 64, buf = st & 1;
    const float* scl = (const float*)(g_shm + S_SC + buf * D_SC);
    bf16x8 ca[4], ct[2], cat[2];
#pragma unroll
    for (int ks = 0; ks < 4; ++ks) ca[ks] = __builtin_bit_cast(bf16x8, na[ks]);
#pragma unroll
    for (int ks = 0; ks < 2; ++ks) {
      ct[ks] = __builtin_bit_cast(bf16x8, mask_frag(nt[ks], arow, ks * 32 + fq * 8, dir, true));
      cat[ks] = __builtin_bit_cast(bf16x8, mask_frag(nat[ks], arow, ks * 32 + fq * 8, dir, false));
    }
    if (st + 1 < nchunk) issue_loads(dir ? cidx - 1 : cidx + 1);
    f32x4 a1[2];
#pragma unroll
    for (int n = 0; n < 2; ++n) a1[n] = (f32x4){0.f, 0.f, 0.f, 0.f};
#pragma unroll
    for (int ks = 0; ks < 4; ++ks)
#pragma unroll
      for (int n = 0; n < 2; ++n) {
        bf16x8 b = *(const bf16x8*)(g_shm + S_ST + (16 * n + fr) * 272 + (ks * 32 + fq * 8) * 2);
        a1[n] = __builtin_amdgcn_mfma_f32_16x16x32_bf16(ca[ks], b, a1[n], 0, 0, 0);
      }
    if (w < 4) {
      const int t0 = 16 * w + fq * 4;
      const f32x4 eg = *(const f32x4*)(scl + t0), be = *(const f32x4*)(scl + 128 + t0);
#pragma unroll
      for (int n = 0; n < 2; ++n) {
        u32x2 vv = *(const u32x2*)(g_shm + S_VT + buf * D_VT + (n * 16 + fr) * 144 + t0 * 2);
        float r0 = be[0] * (bf_lo(vv[0]) - eg[0] * a1[n][0]), r1 = be[1] * (bf_hi(vv[0]) - eg[1] * a1[n][1]);
        float r2 = be[2] * (bf_lo(vv[1]) - eg[2] * a1[n][2]), r3 = be[3] * (bf_hi(vv[1]) - eg[3] * a1[n][3]);
        u32x2 o; o[0] = pk_bf16(r0, r1); o[1] = pk_bf16(r2, r3);
        *(u32x2*)(g_shm + S_RT + (n * 16 + fr) * 144 + t0 * 2) = o;
      }
    }
    __syncthreads();
    {
      const int mt = w & 3, nn = w >> 2, t0 = mt * 16 + fq * 4;
      f32x4 vn = (f32x4){0.f, 0.f, 0.f, 0.f};
#pragma unroll
      for (int ks = 0; ks < 2; ++ks) {
        bf16x8 b = *(const bf16x8*)(g_shm + S_RT + (nn * 16 + fr) * 144 + (ks * 32 + fq * 8) * 2);
        vn = __builtin_amdgcn_mfma_f32_16x16x32_bf16(ct[ks], b, vn, 0, 0, 0);
      }
      const f32x4 el = *(const f32x4*)(scl + 64 + t0);
      u32x2 o; o[0] = pk_bf16(vn[0], vn[1]); o[1] = pk_bf16(vn[2], vn[3]);
      *(u32x2*)(g_shm + S_VN + (nn * 16 + fr) * 144 + t0 * 2) = o;
      u32x2 o2; o2[0] = pk_bf16(vn[0] * el[0], vn[1] * el[1]); o2[1] = pk_bf16(vn[2] * el[2], vn[3] * el[3]);
      *(u32x2*)(g_shm + S_VNS + (nn * 16 + fr) * 144 + t0 * 2) = o2;
    }
    __syncthreads();
    if (w >= 4) {
      const int t0 = (w - 4) * 16 + fq * 4;
      const f32x4 eg = *(const f32x4*)(scl + t0);
#pragma unroll
      for (int n = 0; n < 2; ++n) a1[n] = a1[n] * eg;
#pragma unroll
      for (int ks = 0; ks < 2; ++ks)
#pragma unroll
        for (int n = 0; n < 2; ++n) {
          bf16x8 b = *(const bf16x8*)(g_shm + S_VN + (n * 16 + fr) * 144 + (ks * 32 + fq * 8) * 2);
          a1[n] = __builtin_amdgcn_mfma_f32_16x16x32_bf16(cat[ks], b, a1[n], 0, 0, 0);
        }
#pragma unroll
      for (int n = 0; n < 2; ++n)
#pragma unroll
        for (int j = 0; j < 4; ++j)
          *(bf16_t*)(g_shm + S_OT + buf * D_OT + (t0 + j) * 80 + (n * 16 + fr) * 2) = (bf16_t)(pk_bf16(a1[n][j], 0.f) & 0xffffu);
    }
    {
      const float gl = scl[192];
#pragma unroll
      for (int n = 0; n < 2; ++n) S[n] = S[n] * gl;
#pragma unroll
      for (int ks = 0; ks < 2; ++ks) {
        bf16x8 a = *(const bf16x8*)(g_shm + S_KT + buf * D_KT + (16 * w + fr) * 144 + (ks * 32 + fq * 8) * 2);
#pragma unroll
        for (int n = 0; n < 2; ++n) {
          bf16x8 b = *(const bf16x8*)(g_shm + S_VNS + (n * 16 + fr) * 144 + (ks * 32 + fq * 8) * 2);
          S[n] = __builtin_amdgcn_mfma_f32_16x16x32_bf16(a, b, S[n], 0, 0, 0);
        }
      }
#pragma unroll
      for (int n = 0; n < 2; ++n) {
        u32x2 o; o[0] = pk_bf16(S[n][0], S[n][1]); o[1] = pk_bf16(S[n][2], S[n][3]);
        *(u32x2*)(g_shm + S_ST + (n * 16 + fr) * 272 + (16 * w + fq * 4) * 2) = o;
      }
    }
    if (st + 1 < nchunk) store_tiles(buf ^ 1);
    __syncthreads();
    __builtin_amdgcn_s_waitcnt(0x0F70); __builtin_amdgcn_sched_barrier(0);
    if (tid < 256) { const int r = tid >> 2, cc = tid & 3;
      *(u32x4*)(obuf + (size_t)(row0 + r) * old_ + dvoff + cc * 8) = *(const u32x4*)(g_shm + S_OT + buf * D_OT + r * 80 + cc * 16); }
    asm volatile("" :: "v"(tch));
    if (st + 3 < nchunk) touch(dir ? cidx - 3 : cidx + 3);
  }
  __syncthreads();
  if (!lat) {
    float* dst = p.out + (size_t)NTOK * 1024 + (((size_t)sidx * 2 + dir) * 4 + h) * 16384;
#pragma unroll
    for (int n = 0; n < 2; ++n)
#pragma unroll
      for (int j = 0; j < 4; ++j) dst[(16 * w + fq * 4 + j) * 128 + q4 * 32 + n * 16 + fr] = S[n][j];
  }
}

__device__ __forceinline__ void phase4(const P& p) {
  const int b = BIDX(), G = GRIDX();
  if (G >= 256 && (G & 7) == 0) {
    const int x = b & 7, y = b >> 3;
    if (y < 16) scan_item(p, ((x * 4 + (y >> 2)) << 2) | (y & 3));
    else {
      const int ny = (G >> 3) - 16;
      for (int q = y - 16; q < 128; q += ny)
        scan_item(p, 128 + (((q >> 2) * 8 + x) << 2 | (q & 3)));
      cvt_loop(p, 1216 + (b - 128), 5440, G - 128, opaque_tid());
    }
  } else {
    for (int it = b; it < 128 + 1024; it += G) scan_item(p, it);
    cvt_loop(p, 1216 + b, 5440, G, opaque_tid());
  }
}

__device__ __forceinline__ void phase5(const P& p) {
  const int tid = opaque_tid();
  {
    const int lane = tid & 63, wid = tid >> 6;
    float* sh2 = (float*)g_shm;
    const float* mod = (const float*)(p.ws + OFF_MOD);
#pragma unroll 10
    for (int idx = tid; idx < 10240; idx += NTHREADS) { int lc = idx >> 10, k = idx & 1023; sh2[idx] = mod[(size_t)lc * 6144 + 3 * 1024 + k]; }
    __syncthreads();
    const bf16_t* Wgu = (const bf16_t*)(p.ws + OFF_WGU);
    float* sW = (float*)(p.ws + OFF_SW);
    for (int r = BIDX() * 8 + wid; r < 2 * 5632; r += GRIDX() * 8) {
      const int l = r / 5632, n = r % 5632;
      float a[5] = {0.f, 0.f, 0.f, 0.f, 0.f};
#pragma unroll
      for (int i = 0; i < 2; ++i) {
        const int k = i * 512 + lane * 8;
        float w[8]; unpack8(*(const u32x4*)(Wgu + ((size_t)l * 5632 + n) * 1024 + k), w);
#pragma unroll
        for (int c = 0; c < 5; ++c) {
          const float* s = sh2 + (l * 5 + c) * 1024 + k;
#pragma unroll
          for (int e = 0; e < 8; ++e) a[c] += w[e] * s[e];
        }
      }
#pragma unroll
      for (int c = 0; c < 5; ++c) { float v = wave_sum(a[c]); if (lane == 0) sW[((size_t)l * 5 + c) * 5632 + n] = v; }
    }
  }
  bf16_t* CAT = (bf16_t*)(p.ws + OFF_CAT); const bf16_t* OB = (const bf16_t*)(p.ws + OFF_OB); const bf16_t* GS = (const bf16_t*)(p.ws + OFF_GS);
  const int l16 = tid & 15, grp = tid >> 4;
  float gn[8];
#pragma unroll
  for (int e = 0; e < 8; ++e) gn[e] = p.o_norm_g[l16 * 8 + e];
  const int pstep = GRIDX() * 32;
  for (int pr = BIDX() * 32 + grp; pr < NTOK * 4; pr += 2 * pstep) {
    const int pr1 = pr + pstep; const bool has1 = pr1 < NTOK * 4; const int q1 = has1 ? pr1 : pr;
    const int row = pr >> 2, h = pr & 3, row1 = q1 >> 2, h1 = q1 & 3;
    const u32x4 la = *(const u32x4*)(CAT + (size_t)row * 1024 + h * 128 + l16 * 8), lb = *(const u32x4*)(OB + (size_t)row * 512 + h * 128 + l16 * 8), lg = *(const u32x4*)(GS + (size_t)row * 512 + h * 128 + l16 * 8);
    const u32x4 ma = *(const u32x4*)(CAT + (size_t)row1 * 1024 + h1 * 128 + l16 * 8), mb = *(const u32x4*)(OB + (size_t)row1 * 512 + h1 * 128 + l16 * 8), mg = *(const u32x4*)(GS + (size_t)row1 * 512 + h1 * 128 + l16 * 8);
    float a[8], b[8], g[8], c[8], d[8], f[8];
    unpack8(la, a); unpack8(lb, b); unpack8(lg, g); unpack8(ma, c); unpack8(mb, d); unpack8(mg, f);
    float ss = 0.f, st = 0.f;
#pragma unroll
    for (int e = 0; e < 8; ++e) { a[e] += b[e]; ss += a[e] * a[e]; c[e] += d[e]; st += c[e] * c[e]; }
    ss = sum16(ss); st = sum16(st);
    const float ri = rsqrtf(ss * (1.f / 128.f) + EPSF), rj = rsqrtf(st * (1.f / 128.f) + EPSF);
#pragma unroll
    for (int e = 0; e < 8; ++e) { a[e] = a[e] * ri * gn[e] * g[e]; c[e] = c[e] * rj * gn[e] * f[e]; }
    *(u32x4*)(CAT + (size_t)row * 1024 + h * 128 + l16 * 8) = pack8(a);
    if (has1) *(u32x4*)(CAT + (size_t)row1 * 1024 + h1 * 128 + l16 * 8) = pack8(c);
  }
}

__device__ __forceinline__ void phase9(const P& p) {
  const int tid = opaque_tid();
  const bf16_t* X = (const bf16_t*)p.out; const float* rsq = (const float*)(p.ws + OFF_RSQ); const float* mod = (const float*)(p.ws + OFF_MOD);
  bf16_t* MX = (bf16_t*)(p.ws + OFF_R1);
  float* rinv = (float*)g_shm;
  char* XS = g_shm + 256;
  const int c4 = tid & 255, half = tid >> 8;
  const int col = c4 * 4, win = 2 << (col >> 8), hw = win >> 1;
  for (int seg = BIDX(); seg < NTOK / 32; seg += GRIDX()) {
    const int row0 = seg * 32;
    int base, L; if (row0 < NCTX) { base = (row0 >> 8) << 8; L = 256; } else { base = NCTX + (((row0 - NCTX) >> 12) << 12); L = 4096; }
    const int p0 = row0 - base;
    __syncthreads();
#pragma unroll
    for (int i = 0; i < 12; ++i) {
      const int idx = tid + 512 * i, r = idx >> 7, cc = idx & 127, q = p0 - 8 + r;
      u32x4 v = (u32x4){0u, 0u, 0u, 0u};
      if (q >= 0 && q < L) v = *(const u32x4*)(X + (size_t)(base + q) * 1024 + cc * 8);
      *(u32x4*)(XS + r * 2048 + cc * 16) = v;
    }
    if (tid < 64) {
      int q = p0 - 16 + tid;
      if (q >= 0 && q < L) { int g = base + q; rinv[tid] = rsqrtf((rsq[g] + rsq[NTOK + g] + rsq[2 * NTOK + g] + rsq[3 * NTOK + g]) * (1.f / 1024.f) + EPSF); }
      else rinv[tid] = 0.f;
    }
    __syncthreads();
    const float* mc = mod + ((size_t)5 + row_cond(row0)) * 6144;
    f32x4 Gm;
    { f32x4 ng = *(const f32x4*)(p.norm_mix_g + 1024 + col), sc = *(const f32x4*)(mc + 1024 + col); Gm = ng * (sc + 1.f); }
    const int ps = p0 + half * 16;
    auto xn = [&](int q) -> f32x4 {
      const u32x2 xr = *(const u32x2*)(XS + (q - p0 + 8) * 2048 + col * 2);
      return (f32x4){bf_lo(xr[0]), bf_hi(xr[0]), bf_lo(xr[1]), bf_hi(xr[1])} * rinv[q - p0 + 16];
    };
    f32x4 sum = (f32x4){0.f, 0.f, 0.f, 0.f};
    for (int q = ps - hw; q < ps - hw + win; ++q) sum = sum + xn(q);
#pragma unroll 4
    for (int i = 0; i < 16; ++i) {
      const int t = ps + i;
      const int lo = max(t - hw, 0), hi = min(t - hw + win, L);
      const f32x4 xc = xn(t), xo = xn(t - hw), xi = xn(t - hw + win);
      f32x4 m = (sum * (1.f / (float)(hi - lo)) - xc) * Gm;
      u32x2 o; o[0] = pk_bf16(m[0], m[1]); o[1] = pk_bf16(m[2], m[3]);
      *(u32x2*)(MX + (size_t)(base + t) * 1024 + col) = o;
      sum = sum - xo + xi;
    }
  }
}

__device__ __forceinline__ void phase13(const P& p) {
  const int tid = opaque_tid(), lane = tid & 63, wid = tid >> 6;
  const float* rsq = (const float*)(p.ws + OFF_RSQ);
  const bf16_t* XF = (const bf16_t*)(p.ws + OFF_R1);
  const int rstep = GRIDX() * 8;
  for (int row = BIDX() * 8 + wid; row < NTOK; row += 2 * rstep) {
    const int row1 = row + rstep; const bool has1 = row1 < NTOK; const int r1 = has1 ? row1 : row;
    u32x2 xa[4], xb[4];
#pragma unroll
    for (int i = 0; i < 4; ++i) { const int k = i * 256 + lane * 4; xa[i] = *(const u32x2*)(XF + (size_t)row * 1024 + k); xb[i] = *(const u32x2*)(XF + (size_t)r1 * 1024 + k); }
    const float ria = rsqrtf((rsq[row] + rsq[NTOK + row] + rsq[2 * NTOK + row] + rsq[3 * NTOK + row]) * (1.f / 1024.f) + EPSF);
    const float rib = rsqrtf((rsq[r1] + rsq[NTOK + r1] + rsq[2 * NTOK + r1] + rsq[3 * NTOK + r1]) * (1.f / 1024.f) + EPSF);
#pragma unroll
    for (int i = 0; i < 4; ++i) {
      const int k = i * 256 + lane * 4;
      const f32x4 g = *(const f32x4*)(p.final_g + k);
      const f32x4 va = (f32x4){bf_lo(xa[i][0]), bf_hi(xa[i][0]), bf_lo(xa[i][1]), bf_hi(xa[i][1])};
      const f32x4 vb = (f32x4){bf_lo(xb[i][0]), bf_hi(xb[i][0]), bf_lo(xb[i][1]), bf_hi(xb[i][1])};
      *(f32x4*)(p.out + (size_t)row * 1024 + k) = va * ria * g;
      if (has1) *(f32x4*)(p.out + (size_t)row1 * 1024 + k) = vb * rib * g;
    }
  }
}

constexpr int NPHASE = 14;
template <int LO, int HI>
__global__ void __launch_bounds__(NTHREADS, 2) fwd_kernel(P p) {
  p.wv = __builtin_amdgcn_readfirstlane((int)(threadIdx.x >> 6));
  if constexpr (HI - LO > 1) { if (p.phase_lo == 0x7fffffff) cg::this_grid().sync();
    grid_bar_init(p); }
#define PH(k, call) if constexpr (LO <= (k) && (k) < HI) { if constexpr ((k) > LO) { grid_bar(p); } call; }
  PH(0, phase0(p))
  PH(1, phase1(p))
  PH(2, gemm_inproj(p))
  PH(3, phase3(p))
  PH(4, phase4(p))
  PH(5, phase5(p))
  PH(6, gemm_resid(p, 0, 0, (const bf16_t*)(p.ws + OFF_CAT), 1024, (const bf16_t*)(p.ws + OFF_WOUT), 1024, 16, (bf16_t*)(p.ws + OFF_R1)))
  PH(7, gemm_ffn_gu(p, 0, (const bf16_t*)(p.ws + OFF_R1)))
  PH(8, gemm_resid(p, 1, 0, (const bf16_t*)(p.ws + OFF_ACT), 2816, (const bf16_t*)(p.ws + OFF_WDN), 2816, 44, (bf16_t*)(p.ws + OFF_R1)))
  PH(9, phase9(p))
  PH(10, gemm_resid(p, 2, 1, (const bf16_t*)(p.ws + OFF_R1), 1024, (const bf16_t*)(p.ws + OFF_WPOOL), 256, 4, (bf16_t*)(p.ws + OFF_R1)))
  PH(11, gemm_ffn_gu(p, 1, (const bf16_t*)(p.ws + OFF_R1)))
  PH(12, gemm_resid(p, 1, 1, (const bf16_t*)(p.ws + OFF_ACT), 2816, (const bf16_t*)(p.ws + OFF_WDN) + (size_t)1024 * 2816, 2816, 44, (bf16_t*)(p.ws + OFF_R1)))
  PH(13, phase13(p))
#undef PH
}

__global__ void cks_kernel(const u32* ptr, size_t nwords, unsigned long long* slot) {
  unsigned long long s = 0;
  for (size_t i = (size_t)blockIdx.x * blockDim.x + threadIdx.x; i < nwords; i += (size_t)gridDim.x * blockDim.x) s += (unsigned long long)ptr[i] * (unsigned long long)((i & 1023) + 1);
  for (int o = 32; o > 0; o >>= 1) s += __shfl_xor(s, o, 64);
  if ((threadIdx.x & 63) == 0) atomicAdd(slot, s);
}
__global__ void cmp_kernel(const unsigned long long* slots, int nbuf, float* out, int n_y, int n_all) {
  int code = 0;
  for (int b = 0; b < nbuf; ++b) if (slots[b] != slots[64 + b]) { code = b + 1; break; }
  const float c = sqrtf(100.f * (float)code);
  for (int i = blockIdx.x * blockDim.x + threadIdx.x; i < n_all; i += gridDim.x * blockDim.x) out[i] = i < n_y ? c : 0.f;
}

__global__ void sanitize_kernel(float* o, int n) {
  for (int i = blockIdx.x * blockDim.x + threadIdx.x; i < n; i += gridDim.x * blockDim.x) { float v = o[i]; if (!(fabsf(v) < 3.0e38f)) o[i] = 0.f; }
}

extern "C" void kernel_launch(void* const* d_in, const int* in_sizes, int n_in, void* d_out, int out_size, void* d_ws, size_t ws_size, hipStream_t stream) {
  static int grid_blocks = 0;
#if COOP
  const void* kfn = (const void*)fwd_kernel<0, NPHASE>;
#else
  const void* kfns[NPHASE] = {(const void*)fwd_kernel<0, 1>, (const void*)fwd_kernel<1, 2>, (const void*)fwd_kernel<2, 3>, (const void*)fwd_kernel<3, 4>,
                              (const void*)fwd_kernel<4, 5>, (const void*)fwd_kernel<5, 6>, (const void*)fwd_kernel<6, 7>, (const void*)fwd_kernel<7, 8>,
                              (const void*)fwd_kernel<8, 9>, (const void*)fwd_kernel<9, 10>, (const void*)fwd_kernel<10, 11>, (const void*)fwd_kernel<11, 12>,
                              (const void*)fwd_kernel<12, 13>, (const void*)fwd_kernel<13, 14>};
#endif
  if (!grid_blocks) {
    int dev = 0, cus = 0;
    (void)hipGetDevice(&dev);
    (void)hipDeviceGetAttribute(&cus, hipDeviceAttributeMultiprocessorCount, dev);
#if COOP
    (void)hipFuncSetAttribute(kfn, hipFuncAttributeMaxDynamicSharedMemorySize, LDS_BYTES);
    int per_cu = 0;
    (void)hipOccupancyMaxActiveBlocksPerMultiprocessor(&per_cu, kfn, NTHREADS, LDS_BYTES);
    if (per_cu < 1) fprintf(stderr, "occupancy query returned %d\n", per_cu);
#else
    for (int i = 0; i < NPHASE; ++i) (void)hipFuncSetAttribute(kfns[i], hipFuncAttributeMaxDynamicSharedMemorySize, LDS_BYTES);
#endif
    grid_blocks = cus >= 8 ? (cus / 8) * 8 : 256;
  }
  P p{};
  p.x_prompt = (const float*)d_in[0]; p.x_sample = (const float*)d_in[1]; p.state = (const float*)d_in[2]; p.c = (const float*)d_in[3];
  p.c_ctx = (const float*)d_in[4]; p.norm_mix_g = (const float*)d_in[5]; p.norm_ffn_g = (const float*)d_in[6]; p.w_ada = (const float*)d_in[7];
  p.b_ada = (const float*)d_in[8]; p.w_in = (const float*)d_in[9]; p.conv_qkv = (const float*)d_in[10]; p.a_log = (const float*)d_in[11];
  p.dt_bias = (const float*)d_in[12]; p.o_norm_g = (const float*)d_in[13]; p.conv_b = (const float*)d_in[14]; p.w_out = (const float*)d_in[15];
  p.w_pool = (const float*)d_in[16]; p.pool_scale = (const float*)d_in[17]; p.w_gate = (const float*)d_in[18]; p.w_up = (const float*)d_in[19];
  p.ffn_conv = (const float*)d_in[20]; p.w_down = (const float*)d_in[21]; p.final_g = (const float*)d_in[22];
  p.out = (float*)d_out; p.ws = (char*)d_ws; p.nblk = grid_blocks; p.wv = 0;
#if COOP
  p.phase_lo = 0; p.phase_hi = NPHASE;
  void* args[] = {&p};
  (void)hipMemsetAsync((char*)d_ws + OFF_BAR, 0, XCD_BAR_WORDS * 4, stream);
  hipError_t e = hipLaunchCooperativeKernel(kfn, dim3(grid_blocks), dim3(NTHREADS), args, LDS_BYTES, stream);
  if (e != hipSuccess) fprintf(stderr, "cooperative launch failed: %s (grid %d)\n", hipGetErrorString(e), grid_blocks);
#else
  p.phase_lo = 0; p.phase_hi = 1;
  void* args[] = {&p};
#ifdef DBG
  {
    const size_t OFF_DBG = (size_t)255 * 1024 * 1024;
    unsigned long long* slots = (unsigned long long*)((char*)d_ws + OFF_DBG);
    (void)hipMemsetAsync(slots, 0, 4096, stream);
    struct CB { int after; const void* ptr; size_t bytes; };
    char* ws = (char*)d_ws; char* o = (char*)d_out;
    const CB cbs[] = {
      {1, ws + OFF_MOD, (size_t)2 * 5 * 6144 * 4}, {1, ws + OFF_WIN, OFF_SMALL}, {1, ws + OFF_SW, (size_t)2 * 5 * 5632 * 4}, {1, ws + OFF_PE, (size_t)64 * 512 * 4},
      {1, ws + OFF_G, (size_t)NTOK * 32}, {1, ws + OFF_BETA, (size_t)NTOK * 32}, {1, o, (size_t)NTOK * 4096}, {1, ws + OFF_R1, SZ_R1},
      {2, ws + OFF_Q, SZ_QKV}, {2, ws + OFF_K, SZ_QKV}, {2, ws + OFF_V, SZ_QKV}, {2, ws + OFF_GS, SZ_QKV},
      {3, ws + OFF_TP, (size_t)1536 * 8192}, {3, ws + OFF_AP, (size_t)1536 * 8192},
      {4, ws + OFF_OB, SZ_QKV}, {4, o + (size_t)NTOK * 4096, (size_t)32 * 2 * 4 * 16384 * 4},
      {5, ws + OFF_CAT, SZ_R1},
      {6, ws + OFF_R1, SZ_R1}, {6, o, (size_t)NTOK * 4096}, {6, ws + OFF_RSQ, (size_t)4 * NTOK * 4}};
    const int ncb = sizeof(cbs) / sizeof(cbs[0]);
    for (int run = 0; run < 2; ++run) {
      (void)hipMemsetAsync(d_ws, run ? 0xAA : 0x55, OFF_DBG, stream);
      (void)hipMemsetAsync(d_out, run ? 0xAA : 0x55, (size_t)out_size * 4, stream);
      for (int ph = 0; ph <= 6; ++ph) {
        (void)hipLaunchKernel(kfns[ph], dim3(grid_blocks), dim3(NTHREADS), args, LDS_BYTES, stream);
        for (int b = 0; b < ncb; ++b) if (cbs[b].after == ph)
          hipLaunchKernelGGL(cks_kernel, dim3(1024), dim3(256), 0, stream, (const u32*)cbs[b].ptr, cbs[b].bytes / 4, slots + run * 64 + b);
      }
    }
    hipLaunchKernelGGL(cmp_kernel, dim3(1024), dim3(256), 0, stream, (const unsigned long long*)slots, ncb, (float*)d_out, NTOK * 1024, out_size);
  }
#else
  for (int ph = 0; ph <= STOP_AFTER; ++ph) {
    hipError_t e = hipLaunchKernel(kfns[ph], dim3(grid_blocks), dim3(NTHREADS), args, LDS_BYTES, stream);
    if (e != hipSuccess) fprintf(stderr, "launch %d failed: %s\n", ph, hipGetErrorString(e));
  }
#ifdef SANITIZE
  hipLaunchKernelGGL(sanitize_kernel, dim3(1024), dim3(256), 0, stream, (float*)d_out, out_size);
#endif
#endif
#endif
}
```

```cpp
#include <hip/hip_runtime.h>
#include <hip/hip_cooperative_groups.h>
#include <cstdio>
namespace cg = cooperative_groups;

#ifndef COOP
#define COOP 1
#endif
#ifndef STOP_AFTER
#define STOP_AFTER 13
#endif


typedef unsigned short bf16_t;
typedef unsigned int u32;
typedef short bf16x8 __attribute__((ext_vector_type(8)));
typedef float f32x4 __attribute__((ext_vector_type(4)));
typedef u32 u32x4 __attribute__((ext_vector_type(4)));
typedef u32 u32x2 __attribute__((ext_vector_type(2)));

constexpr int NTOK = 24576, NCTX = 8192;
constexpr int NTHREADS = 512;
constexpr float EPSF = 1e-6f;
constexpr int LDS_TILE_BYTES = 256 * 544;
constexpr int LDS_BYTES = LDS_TILE_BYTES + 16;

constexpr size_t OFF_WIN = 0;
constexpr size_t OFF_WOUT = OFF_WIN + (size_t)3584 * 1024 * 2;
constexpr size_t OFF_WPOOL = OFF_WOUT + (size_t)1024 * 1024 * 2;
constexpr size_t OFF_WGU = OFF_WPOOL + (size_t)4 * 256 * 256 * 2;
constexpr size_t OFF_WDN = OFF_WGU + (size_t)2 * 5632 * 1024 * 2;
constexpr size_t OFF_SMALL = OFF_WDN + (size_t)2 * 1024 * 2816 * 2;
constexpr size_t OFF_MOD = OFF_SMALL;
constexpr size_t OFF_SW = OFF_MOD + (size_t)2 * 5 * 6144 * 4;
constexpr size_t OFF_PE = OFF_SW + (size_t)2 * 5 * 5632 * 4;
constexpr size_t OFF_G = OFF_PE + (size_t)64 * 512 * 4;
constexpr size_t OFF_BETA = OFF_G + (size_t)NTOK * 8 * 4;
constexpr size_t OFF_RSQ = OFF_BETA + (size_t)NTOK * 8 * 4;
constexpr size_t OFF_BAR = OFF_RSQ + (size_t)4 * NTOK * 4;
constexpr size_t OFF_R1 = OFF_SMALL + (size_t)4 * 1024 * 1024;
constexpr size_t SZ_R1 = (size_t)NTOK * 1024 * 2;
constexpr size_t OFF_BIG = OFF_R1 + SZ_R1;
constexpr size_t SZ_QKV = (size_t)NTOK * 512 * 2;
constexpr size_t OFF_Q = OFF_BIG, OFF_K = OFF_Q + SZ_QKV, OFF_V = OFF_K + SZ_QKV, OFF_GS = OFF_V + SZ_QKV, OFF_CAT = OFF_GS + SZ_QKV;
constexpr size_t OFF_ACT = OFF_BIG;
constexpr size_t OFF_TP = OFF_R1, OFF_AP = OFF_TP + (size_t)1536 * 4096 * 2, OFF_OB = OFF_AP + (size_t)1536 * 4096 * 2;

struct P {
  const float *x_prompt, *x_sample, *state, *c, *c_ctx, *norm_mix_g, *norm_ffn_g, *w_ada, *b_ada, *w_in, *conv_qkv, *a_log, *dt_bias,
      *o_norm_g, *conv_b, *w_out, *w_pool, *pool_scale, *w_gate, *w_up, *ffn_conv, *w_down, *final_g;
  float* out;
  char* ws;
  int phase_lo, phase_hi;
  int nblk, wv;
};

extern __shared__ __attribute__((aligned(1024))) char g_shm[];

typedef __bf16 bf16x2v __attribute__((ext_vector_type(2)));
typedef float f32x2v __attribute__((ext_vector_type(2)));
__device__ __forceinline__ u32 pk_bf16(float lo, float hi) { f32x2v f = {lo, hi}; bf16x2v b = __builtin_convertvector(f, bf16x2v); return __builtin_bit_cast(u32, b); }
__device__ __forceinline__ float bf_lo(u32 w) { return __uint_as_float(w << 16); }
__device__ __forceinline__ float bf_hi(u32 w) { return __uint_as_float(w & 0xffff0000u); }
__device__ __forceinline__ float bf2f(bf16_t v) { return __uint_as_float(((u32)v) << 16); }
__device__ __forceinline__ float silu_f(float x) { return x * __builtin_amdgcn_rcpf(1.f + __expf(-x)); }
__device__ __forceinline__ float sigm_f(float x) { return __builtin_amdgcn_rcpf(1.f + __expf(-x)); }
__device__ __forceinline__ void unpack8(u32x4 v, float (&o)[8]) {
  o[0] = bf_lo(v[0]); o[1] = bf_hi(v[0]); o[2] = bf_lo(v[1]); o[3] = bf_hi(v[1]);
  o[4] = bf_lo(v[2]); o[5] = bf_hi(v[2]); o[6] = bf_lo(v[3]); o[7] = bf_hi(v[3]);
}
__device__ __forceinline__ u32x4 pack8(const float (&o)[8]) {
  u32x4 v; v[0] = pk_bf16(o[0], o[1]); v[1] = pk_bf16(o[2], o[3]); v[2] = pk_bf16(o[4], o[5]); v[3] = pk_bf16(o[6], o[7]); return v;
}
template <int CTRL> __device__ __forceinline__ float dpp_mov(float v) {
  return __builtin_bit_cast(float, __builtin_amdgcn_update_dpp(0, __builtin_bit_cast(int, v), CTRL, 0xF, 0xF, true));
}
__device__ __forceinline__ float sum16(float v) {
  v += dpp_mov<0xB1>(v);
  v += dpp_mov<0x4E>(v);
  v += dpp_mov<0x141>(v);
  v += dpp_mov<0x140>(v);
  return v;
}
__device__ __forceinline__ float rdlane(float v, int l) { return __builtin_bit_cast(float, __builtin_amdgcn_readlane(__builtin_bit_cast(int, v), l)); }
__device__ __forceinline__ float wave_sum(float v) {
  v = sum16(v);
  return (rdlane(v, 0) + rdlane(v, 16)) + (rdlane(v, 32) + rdlane(v, 48));
}
template <int CTRL, int ROWMASK> __device__ __forceinline__ float dpp_add(float v) {
  return v + __builtin_bit_cast(float, __builtin_amdgcn_update_dpp(0, __builtin_bit_cast(int, v), CTRL, ROWMASK, 0xF, CTRL < 0x140));
}
__device__ __forceinline__ float wave_prefix(float g, int  ) {
  g = dpp_add<0x111, 0xF>(g);
  g = dpp_add<0x112, 0xF>(g);
  g = dpp_add<0x114, 0xF>(g);
  g = dpp_add<0x118, 0xF>(g);
  g = dpp_add<0x142, 0xA>(g);
  g = dpp_add<0x143, 0xC>(g);
  return g;
}
#define GRIDX() (p.nblk)
__device__ __forceinline__ int BIDX() { return (int)blockIdx.x; }
__device__ __forceinline__ int opaque_tid_w(int wv) { unsigned m = ~0u; asm volatile("" : "+s"(m)); int t = (wv << 6) | (int)__builtin_amdgcn_mbcnt_hi(m, __builtin_amdgcn_mbcnt_lo(m, 0u)); asm volatile("" : "+v"(t)); return t; }
#define opaque_tid() opaque_tid_w(p.wv)
__device__ __forceinline__ int row_cond(int row) { return row < NCTX ? 0 : 1 + ((row - NCTX) >> 12); }


#define XB_TMO      128
#define XB_XCNT(j)  (256  + 64 * (j))
#define XB_XSUB(j)  (1280 + 64 * (j))
#define XB_XGEN(j)  (2304 + 64 * (j))
#define XB_TOP      3328
#define XB_TOPGEN   3392
#define XCD_BAR_WORDS 3456
#define XB_SPIN_CAP (1u << 18)
#define LAS __attribute__((address_space(3)))
__device__ __forceinline__ unsigned xb_ld(unsigned* q)              { return __hip_atomic_load(q, __ATOMIC_RELAXED, __HIP_MEMORY_SCOPE_AGENT); }
__device__ __forceinline__ unsigned xb_add(unsigned* q, unsigned v) { return __hip_atomic_fetch_add(q, v, __ATOMIC_RELAXED, __HIP_MEMORY_SCOPE_AGENT); }
__device__ __forceinline__ unsigned xb_xcc_id() { return (unsigned)__builtin_amdgcn_s_getreg((3 << 11) | 20) & 0xFu; }
#define XB_SPIN(cond, bar) do { unsigned _sp = 0; while (cond) { __builtin_amdgcn_s_sleep(1); \
    if ((++_sp & 255u) == 0u) { if (xb_ld(&(bar)[XB_TMO])) break; if (_sp > XB_SPIN_CAP) { atomicAdd(&(bar)[XB_TMO], 1u); break; } } } } while (0)
__device__ __forceinline__ void xb_complete(unsigned* bar, unsigned x, unsigned G, unsigned& nloc, unsigned& nx) {
  unsigned sum, cnt, mine, sp = 0u;
  for (;;) {
    sum = 0u; cnt = 0u; mine = 0u;
#pragma unroll
    for (unsigned j = 0; j < 16; ++j) { const unsigned c = xb_ld(&bar[XB_XCNT(j)]); sum += c; cnt += (c > 0u) ? 1u : 0u; mine = (j == x) ? c : mine; }
    if (sum == G) break;
    __builtin_amdgcn_s_sleep(1);
    if ((++sp & 255u) == 0u) { if (xb_ld(&bar[XB_TMO])) break; if (sp > XB_SPIN_CAP) { atomicAdd(&bar[XB_TMO], 1u); break; } }
  }
  nloc = mine > 0u ? mine : 1u; nx = cnt > 0u ? cnt : 1u;
}
__device__ __forceinline__ void grid_bar_init(const P& p) {
  const int tid = opaque_tid();
  volatile LAS unsigned* st = (volatile LAS unsigned*)(g_shm + LDS_TILE_BYTES);
  if (tid == 0) { st[0] = 0u; st[1] = 0u; (void)xb_add(&((unsigned*)(p.ws + OFF_BAR))[XB_XCNT(xb_xcc_id())], 1u); }
  __syncthreads();
}
__device__ __forceinline__ void grid_bar(const P& p) {
  const int tid = opaque_tid();
  asm volatile("s_waitcnt vmcnt(0)" ::: "memory");
  __syncthreads();
  if (tid == 0) {
    unsigned* bar = (unsigned*)(p.ws + OFF_BAR);
    volatile LAS unsigned* st = (volatile LAS unsigned*)(g_shm + LDS_TILE_BYTES);
    const unsigned x = xb_xcc_id();
    __builtin_amdgcn_s_waitcnt(0);
    unsigned nloc = st[0], nx = st[1];
    if (nloc == 0u) { xb_complete(bar, x, (unsigned)p.nblk, nloc, nx); st[0] = nloc; st[1] = nx; }
    const unsigned old = xb_add(&bar[XB_XSUB(x)], 1u);
    const unsigned gen = old / nloc;
    if (old + 1u == (gen + 1u) * nloc) {
      __builtin_amdgcn_fence(__ATOMIC_RELEASE, "agent");
      asm volatile("s_waitcnt vmcnt(0)" ::: "memory");
      const unsigned og = xb_add(&bar[XB_TOP], 1u);
      const unsigned tg = og / nx;
      if (og + 1u == (tg + 1u) * nx) xb_add(&bar[XB_TOPGEN], 1u);
      else XB_SPIN(xb_ld(&bar[XB_TOPGEN]) == tg, bar);
      __builtin_amdgcn_fence(__ATOMIC_ACQUIRE, "agent");
      xb_add(&bar[XB_XGEN(x)], 1u);
      asm volatile("s_waitcnt vmcnt(0)" ::: "memory");
    } else {
      XB_SPIN(xb_ld(&bar[XB_XGEN(x)]) == gen, bar);
      __builtin_amdgcn_fence(__ATOMIC_ACQUIRE, "agent");
      asm volatile("s_waitcnt vmcnt(0)" ::: "memory");
    }
  }
  __syncthreads();
}

struct CvtTile { const float* src; bf16_t* dst; int ld_src, ld_dst; };
__device__ __forceinline__ CvtTile cvt_desc(const P& p, int t) {
  bf16_t* Win = (bf16_t*)(p.ws + OFF_WIN); bf16_t* Wout = (bf16_t*)(p.ws + OFF_WOUT); bf16_t* Wpool = (bf16_t*)(p.ws + OFF_WPOOL);
  bf16_t* Wgu = (bf16_t*)(p.ws + OFF_WGU); bf16_t* Wdn = (bf16_t*)(p.ws + OFF_WDN);
  CvtTile d;
  if (t < 896) {
    int j = t >> 4, kc = t & 15, sc;
    if (j < 24) sc = j * 64; else { int jj = j - 24, m = jj >> 2, part = jj & 3; sc = (part == 0 ? 2064 : part == 1 ? 2576 : part == 2 ? 3088 : 1536) + m * 64; }
    d.src = p.w_in + (size_t)kc * 64 * 3600 + sc; d.ld_src = 3600; d.dst = Win + (size_t)j * 64 * 1024 + kc * 64; d.ld_dst = 1024;
  } else if (t < 1152) {
    int u = t - 896, j = u >> 4, kc = u & 15;
    d.src = p.w_out + (size_t)kc * 64 * 1024 + j * 64; d.ld_src = 1024; d.dst = Wout + (size_t)j * 64 * 1024 + kc * 64; d.ld_dst = 1024;
  } else if (t < 1216) {
    int u = t - 1152, g = u >> 4, j = (u >> 2) & 3, kc = u & 3;
    d.src = p.w_pool + (size_t)g * 65536 + (size_t)kc * 64 * 256 + j * 64; d.ld_src = 256; d.dst = Wpool + (size_t)g * 65536 + (size_t)j * 64 * 256 + kc * 64; d.ld_dst = 256;
  } else if (t < 4032) {
    int u = t - 1216, l = u / 1408, v = u % 1408, j = v >> 4, kc = v & 15, nt = j >> 2, part = j & 3;
    d.src = (part < 2 ? p.w_gate : p.w_up) + (size_t)l * 1024 * 2816 + (size_t)kc * 64 * 2816 + nt * 128 + (part & 1) * 64; d.ld_src = 2816;
    d.dst = Wgu + (size_t)l * 5632 * 1024 + (size_t)j * 64 * 1024 + kc * 64; d.ld_dst = 1024;
  } else {
    int u = t - 4032, l = u / 704, v = u % 704, j = v / 44, kc = v % 44;
    d.src = p.w_down + (size_t)l * 2816 * 1024 + (size_t)kc * 64 * 1024 + j * 64; d.ld_src = 1024;
    d.dst = Wdn + (size_t)l * 1024 * 2816 + (size_t)j * 64 * 2816 + kc * 64; d.ld_dst = 2816;
  }
  return d;
}
__device__ __forceinline__ void cvt_loop(const P& p, int t, const int tend, const int tstride, const int tid) {
  float* tile = (float*)g_shm;
  const int kk0 = tid >> 4, c4 = tid & 15, wn = tid >> 3, wkc = tid & 7;
  float4 v0, v1;
  if (t < tend) { CvtTile d = cvt_desc(p, t); v0 = *(const float4*)(d.src + (size_t)kk0 * d.ld_src + c4 * 4); v1 = *(const float4*)(d.src + (size_t)(kk0 + 32) * d.ld_src + c4 * 4); }
  while (t < tend) {
    const CvtTile d = cvt_desc(p, t);
    { float* q = tile + kk0 * 65 + c4 * 4; q[0] = v0.x; q[1] = v0.y; q[2] = v0.z; q[3] = v0.w;
      q = tile + (kk0 + 32) * 65 + c4 * 4; q[0] = v1.x; q[1] = v1.y; q[2] = v1.z; q[3] = v1.w; }
    const int tn = t + tstride;
    if (tn < tend) { CvtTile e = cvt_desc(p, tn); v0 = *(const float4*)(e.src + (size_t)kk0 * e.ld_src + c4 * 4); v1 = *(const float4*)(e.src + (size_t)(kk0 + 32) * e.ld_src + c4 * 4); }
    __syncthreads();
    { float o[8];
#pragma unroll
      for (int e = 0; e < 8; ++e) o[e] = tile[(wkc * 8 + e) * 65 + wn];
      *(u32x4*)(d.dst + (size_t)wn * d.ld_dst + wkc * 8) = pack8(o); }
    __syncthreads();
    t = tn;
  }
}

__device__ __forceinline__ void phase0(const P& p) {
  const int tid = opaque_tid();
  float* sl = (float*)g_shm;
  float* red = (float*)(g_shm + 20480);
#pragma unroll
  for (int i = tid; i < 5120; i += NTHREADS) { int c = i >> 10, k = i & 1023; float v = c == 0 ? p.c_ctx[k] : p.c[(c - 1) * 1024 + k]; sl[i] = silu_f(v); }
  __syncthreads();
  float* mod = (float*)(p.ws + OFF_MOD);
  for (int item = BIDX(); item < 256; item += GRIDX()) {
    const int gcol0 = item * 48, layer = gcol0 / 6144, n0 = gcol0 % 6144;
    if (tid < 504) {
      const int cgp = tid % 12, kg = tid / 12;
      float acc[5][4];
#pragma unroll
      for (int c = 0; c < 5; ++c)
#pragma unroll
        for (int e = 0; e < 4; ++e) acc[c][e] = 0.f;
      for (int k0 = kg; k0 < 1024; k0 += 42 * 8) {
        float4 w[8];
#pragma unroll
        for (int u = 0; u < 8; ++u) { const int k = k0 + 42 * u; w[u] = k < 1024 ? *(const float4*)(p.w_ada + ((size_t)layer * 1024 + k) * 6144 + n0 + cgp * 4) : make_float4(0.f, 0.f, 0.f, 0.f); }
#pragma unroll
        for (int u = 0; u < 8; ++u) {
          const int k = k0 + 42 * u;
          if (k < 1024) {
#pragma unroll
            for (int c = 0; c < 5; ++c) { float s = sl[c * 1024 + k]; acc[c][0] += s * w[u].x; acc[c][1] += s * w[u].y; acc[c][2] += s * w[u].z; acc[c][3] += s * w[u].w; }
          }
        }
      }
#pragma unroll
      for (int c = 0; c < 5; ++c)
#pragma unroll
        for (int e = 0; e < 4; ++e) red[(kg * 5 + c) * 48 + cgp * 4 + e] = acc[c][e];
    }
    __syncthreads();
    if (tid < 240) {
      int c = tid / 48, n = tid % 48; float s = 0.f;
      for (int kg = 0; kg < 42; ++kg) s += red[(kg * 5 + c) * 48 + n];
      mod[((size_t)layer * 5 + c) * 6144 + n0 + n] = s + p.b_ada[layer * 6144 + n0 + n];
    }
    __syncthreads();
  }
  cvt_loop(p, BIDX(), 1216, GRIDX(), tid);
  float* pe = (float*)(p.ws + OFF_PE);
  for (int idx = BIDX() * NTHREADS + tid; idx < 32768; idx += GRIDX() * NTHREADS) {
    int pp = idx >> 9, e = idx & 511, ee = e & 255;
    float omega = 1.0f / powf(10000.0f, (float)ee / 256.0f);
    float a = (float)pp * omega;
    pe[idx] = e < 256 ? sinf(a) : cosf(a);
  }
}

__device__ __forceinline__ void phase1(const P& p) {
  const int tid = opaque_tid(), lane = tid & 63, wid = tid >> 6;
  float* wl = (float*)g_shm;
  const float* mod = (const float*)(p.ws + OFF_MOD);
#pragma unroll 16
  for (int idx = tid; idx < 16384; idx += NTHREADS) { int k = idx >> 4, j = idx & 15; wl[j * 1024 + k] = p.w_in[(size_t)k * 3600 + 2048 + j]; }
  __syncthreads();
  const float* pe = (const float*)(p.ws + OFF_PE);
  bf16_t* h0 = (bf16_t*)(p.ws + OFF_R1);
  float* gb = (float*)(p.ws + OFF_G); float* bb = (float*)(p.ws + OFF_BETA);
  f32x4 Gv[4];
#pragma unroll
  for (int i = 0; i < 4; ++i) Gv[i] = *(const f32x4*)(p.norm_mix_g + i * 256 + lane * 4);
  for (int it = BIDX(); it < NTOK / 16; it += GRIDX()) {
    float h[2][16];
    const int rowA = it * 16 + wid * 2;
    const bool lat = rowA >= NCTX;
    const float* src = lat ? p.x_sample + (size_t)(rowA - NCTX) * 1024 : p.x_prompt + (size_t)rowA * 1024;
    const float* mc = mod + (size_t)row_cond(rowA) * 6144;
    f32x4 xv[2][4], scv[4], shv[4];
#pragma unroll
    for (int rr = 0; rr < 2; ++rr)
#pragma unroll
      for (int i = 0; i < 4; ++i) xv[rr][i] = *(const f32x4*)(src + rr * 1024 + i * 256 + lane * 4);
    if (lat) {
#pragma unroll
      for (int rr = 0; rr < 2; ++rr) {
        const int pos = (rowA + rr - NCTX) & 4095, pr = pos >> 6, pc = pos & 63;
#pragma unroll
        for (int i = 0; i < 4; ++i) { const int k = i * 256 + lane * 4; xv[rr][i] = xv[rr][i] + *(const f32x4*)(pe + (k < 512 ? pr * 512 + k : pc * 512 + k - 512)); }
      }
    }
#pragma unroll
    for (int i = 0; i < 4; ++i) { const int k = i * 256 + lane * 4; scv[i] = *(const f32x4*)(mc + 1024 + k); shv[i] = *(const f32x4*)(mc + k); }
#pragma unroll
    for (int rr = 0; rr < 2; ++rr) {
      const int row = rowA + rr;
      float ss = 0.f;
#pragma unroll
      for (int i = 0; i < 4; ++i) {
        const int k = i * 256 + lane * 4; const f32x4 v = xv[rr][i];
        { u32x2 xo; xo[0] = pk_bf16(v[0], v[1]); xo[1] = pk_bf16(v[2], v[3]); *(u32x2*)((bf16_t*)p.out + (size_t)row * 1024 + k) = xo; }
        ss += v[0] * v[0] + v[1] * v[1] + v[2] * v[2] + v[3] * v[3];
      }
      ss = wave_sum(ss);
      const float rinv = rsqrtf(ss * (1.f / 1024.f) + EPSF);
#pragma unroll
      for (int i = 0; i < 4; ++i) {
        const int k = i * 256 + lane * 4;
        const f32x4 hv = xv[rr][i] * rinv * Gv[i] * (scv[i] + 1.f) + shv[i];
        h[rr][i * 4 + 0] = hv[0]; h[rr][i * 4 + 1] = hv[1]; h[rr][i * 4 + 2] = hv[2]; h[rr][i * 4 + 3] = hv[3];
        u32x2 o; o[0] = pk_bf16(hv[0], hv[1]); o[1] = pk_bf16(hv[2], hv[3]);
        *(u32x2*)(h0 + (size_t)row * 1024 + k) = o;
      }
    }
    f32x2v hp[16];
#pragma unroll
    for (int k = 0; k < 16; ++k) hp[k] = (f32x2v){h[0][k], h[1][k]};
    float my0 = 0.f, my1 = 0.f;
#pragma unroll 2
    for (int j = 0; j < 16; ++j) {
      f32x2v ap = {0.f, 0.f};
#pragma unroll
      for (int i = 0; i < 4; ++i) {
        float4 w = *(const float4*)(wl + j * 1024 + i * 256 + lane * 4);
        ap += w.x * hp[i * 4] + w.y * hp[i * 4 + 1];
        ap += w.z * hp[i * 4 + 2] + w.w * hp[i * 4 + 3];
      }
      float a0 = wave_sum(ap[0]), a1 = wave_sum(ap[1]);
      if (lane == j) { my0 = a0; my1 = a1; }
    }
    if (lane < 16) {
#pragma unroll
      for (int rr = 0; rr < 2; ++rr) {
        const int row = it * 16 + wid * 2 + rr; float v = rr ? my1 : my0;
        if (lane < 8) bb[(size_t)row * 8 + lane] = sigm_f(v);
        else {
          int q = lane - 8; float z = v + p.dt_bias[q];
          float sp = z > 20.f ? z : log1pf(__expf(z));
          gb[(size_t)row * 8 + q] = -__expf(p.a_log[q]) * sp;
        }
      }
    }
  }

}

__device__ __forceinline__ int lds_byte(int r, int c) {
  int st = (r >> 4) * 2 + (c >> 5), ob = (r & 15) * 64 + (c & 31) * 2;
  return st * 1024 + (ob ^ (((ob >> 9) & 1) << 5));
}
__device__ __forceinline__ void stage_rc(int b, int& R, int& C) {
  int st = b >> 10, sb = b & 1023, swz = sb ^ (((sb >> 9) & 1) << 5);
  R = (st >> 1) * 16 + swz / 64;
  C = (st & 1) * 32 + (swz % 64) / 2;
}
constexpr int TILE_B = 256 * 64 * 2, STAGE_B = 2 * TILE_B;
#define WAIT_V0() asm volatile("s_waitcnt vmcnt(0)" ::: "memory")

template <int MT>
__device__ __forceinline__ void gemm_tile(f32x4 (&acc)[MT][4], const bf16_t* A, const u32 (&aoff)[4], const bf16_t* B, const u32 (&boff)[4], int nt, int tid) {
  const int wid = tid >> 6, lane = tid & 63, wr = wid >> 2, wc = wid & 3, fr = lane & 15, fq = lane >> 4;
#pragma unroll
  for (int m = 0; m < MT; ++m)
#pragma unroll
    for (int n = 0; n < 4; ++n) acc[m][n] = (f32x4){0.f, 0.f, 0.f, 0.f};
#define GSTAGE(buf, kt) do { _Pragma("unroll") for (int i = 0; i < 4; ++i) { \
    if (i < MT / 2) __builtin_amdgcn_global_load_lds((const u32*)(A + aoff[i] + (kt) * 64), (__attribute__((address_space(3))) u32*)(g_shm + (buf) * STAGE_B + wid * 1024 + i * 8192), 16, 0, 0); \
    __builtin_amdgcn_global_load_lds((const u32*)(B + boff[i] + (kt) * 64), (__attribute__((address_space(3))) u32*)(g_shm + (buf) * STAGE_B + TILE_B + wid * 1024 + i * 8192), 16, 0, 0); } } while (0)
  GSTAGE(0, 0); WAIT_V0(); __syncthreads();
  for (int t = 0; t < nt; ++t) {
    const int cur = t & 1;
    if (t + 1 < nt) GSTAGE(cur ^ 1, t + 1);
    const char* sa = g_shm + cur * STAGE_B; const char* sb = sa + TILE_B;
#pragma unroll
    for (int ks = 0; ks < 2; ++ks) {
      bf16x8 At[MT], Bf[4];
#pragma unroll
      for (int m = 0; m < MT; ++m) At[m] = *(const bf16x8*)(sa + lds_byte(wr * (MT * 16) + m * 16 + fr, ks * 32 + fq * 8));
#pragma unroll
      for (int n = 0; n < 4; ++n) Bf[n] = *(const bf16x8*)(sb + lds_byte(wc * 64 + n * 16 + fr, ks * 32 + fq * 8));
#pragma unroll
      for (int m = 0; m < MT; ++m)
#pragma unroll
        for (int n = 0; n < 4; ++n) acc[m][n] = __builtin_amdgcn_mfma_f32_16x16x32_bf16(Bf[n], At[m], acc[m][n], 0, 0, 0);
      __builtin_amdgcn_sched_barrier(0);
    }
    WAIT_V0(); __syncthreads();
  }
#undef GSTAGE
}


__device__ __forceinline__ void gemm_tile8p(f32x4 (&acc)[2][2][4][2], const bf16_t* A, size_t ahstep, const u32 (&voffA)[2], const bf16_t* B, size_t bhstep, const u32 (&voffB)[2], int nt, int tid) {
  const int wid = tid >> 6, lane = tid & 63, wr = wid >> 2, wc = wid & 3, fr = lane & 15, fq = lane >> 4;
#pragma unroll
  for (int ai = 0; ai < 2; ++ai)
#pragma unroll
    for (int bj = 0; bj < 2; ++bj)
#pragma unroll
      for (int m = 0; m < 4; ++m)
#pragma unroll
        for (int n = 0; n < 2; ++n) acc[ai][bj][m][n] = (f32x4){0.f, 0.f, 0.f, 0.f};
#define P8_SA(b, h) (g_shm + ((b) * 2 + (h)) * 16384)
#define P8_SB(b, h) (g_shm + (4 + (b) * 2 + (h)) * 16384)
#define P8_STA(b, h, kt) do { _Pragma("unroll") for (int _i = 0; _i < 2; ++_i) \
    __builtin_amdgcn_global_load_lds((const u32*)((const char*)(A + (h) * ahstep + (kt) * 64) + voffA[_i]), (__attribute__((address_space(3))) u32*)(P8_SA(b, h) + wid * 1024 + _i * 8192), 16, 0, 0); } while (0)
#define P8_STB(b, h, kt) do { _Pragma("unroll") for (int _i = 0; _i < 2; ++_i) \
    __builtin_amdgcn_global_load_lds((const u32*)((const char*)(B + (h) * bhstep + (kt) * 64) + voffB[_i]), (__attribute__((address_space(3))) u32*)(P8_SB(b, h) + wid * 1024 + _i * 8192), 16, 0, 0); } while (0)
#define P8_LDA(dst, b, h) do { _Pragma("unroll") for (int m = 0; m < 4; ++m) _Pragma("unroll") for (int k = 0; k < 2; ++k) \
    dst[m][k] = *(const bf16x8*)(P8_SA(b, h) + lds_byte(wr * 64 + m * 16 + fr, k * 32 + fq * 8)); } while (0)
#define P8_LDB(dst, b, h) do { _Pragma("unroll") for (int n = 0; n < 2; ++n) _Pragma("unroll") for (int k = 0; k < 2; ++k) \
    dst[n][k] = *(const bf16x8*)(P8_SB(b, h) + lds_byte(wc * 32 + n * 16 + fr, k * 32 + fq * 8)); } while (0)
#define P8_MMA(ai, bj, Af, Bfr) do { __builtin_amdgcn_s_setprio(1); \
    _Pragma("unroll") for (int m = 0; m < 4; ++m) _Pragma("unroll") for (int n = 0; n < 2; ++n) _Pragma("unroll") for (int k = 0; k < 2; ++k) \
      acc[ai][bj][m][n] = __builtin_amdgcn_mfma_f32_16x16x32_bf16(Bfr[n][k], Af[m][k], acc[ai][bj][m][n], 0, 0, 0); \
    __builtin_amdgcn_s_setprio(0); } while (0)
#define P8_WV(n) asm volatile("s_waitcnt vmcnt(" #n ")" ::: "memory")
#define P8_WL(n) asm volatile("s_waitcnt lgkmcnt(" #n ")" ::: "memory")
#define P8_BAR __builtin_amdgcn_s_barrier()
#define P8_SCHED __builtin_amdgcn_sched_barrier(0)
  bf16x8 At[4][2], B0[2][2], B1[2][2];
  __builtin_amdgcn_s_waitcnt(0x0F70);
  P8_STB(0, 0, 0); P8_STA(0, 0, 0); P8_STB(0, 1, 0); P8_STA(0, 1, 0);
  if (wr == 1) P8_BAR;
  P8_WV(4); P8_BAR;
  P8_STB(1, 0, 1); P8_STA(1, 0, 1); P8_STB(1, 1, 1);
  P8_WV(6); P8_BAR;
  for (int t = 0; t < nt - 2; t += 2) {
    P8_LDB(B0, 0, 0); P8_SCHED; P8_LDA(At, 0, 0); P8_STA(1, 1, t + 1);
    P8_WL(8); P8_BAR; P8_WL(0); P8_MMA(0, 0, At, B0); P8_BAR; P8_SCHED;
    P8_LDB(B1, 0, 1); P8_STB(0, 0, t + 2);
    P8_BAR; P8_WL(0); P8_MMA(0, 1, At, B1); P8_BAR;
    P8_LDA(At, 0, 1); P8_STA(0, 0, t + 2);
    P8_BAR; P8_WL(0); P8_MMA(1, 0, At, B0); P8_BAR; P8_SCHED;
    P8_STB(0, 1, t + 2);
    P8_WV(6); P8_BAR; P8_MMA(1, 1, At, B1); P8_BAR;
    P8_LDB(B0, 1, 0); P8_SCHED; P8_LDA(At, 1, 0); P8_STA(0, 1, t + 2);
    P8_WL(8); P8_BAR; P8_WL(0); P8_MMA(0, 0, At, B0); P8_BAR; P8_SCHED;
    P8_LDB(B1, 1, 1); P8_STB(1, 0, t + 3);
    P8_BAR; P8_WL(0); P8_MMA(0, 1, At, B1); P8_BAR;
    P8_LDA(At, 1, 1); P8_STA(1, 0, t + 3);
    P8_BAR; P8_WL(0); P8_MMA(1, 0, At, B0); P8_BAR; P8_SCHED;
    P8_STB(1, 1, t + 3);
    P8_WV(6); P8_BAR; P8_MMA(1, 1, At, B1); P8_BAR;
  }
  { P8_LDB(B0, 0, 0); P8_LDA(At, 0, 0); P8_STA(1, 1, nt - 1);
    P8_BAR; P8_WL(0); P8_MMA(0, 0, At, B0); P8_BAR;
    P8_LDB(B1, 0, 1); P8_BAR; P8_WL(0); P8_MMA(0, 1, At, B1); P8_BAR;
    P8_LDA(At, 0, 1); P8_WV(4); P8_BAR; P8_WL(0); P8_MMA(1, 0, At, B0); P8_MMA(1, 1, At, B1); P8_BAR; }
  { P8_LDB(B0, 1, 0); P8_LDA(At, 1, 0); P8_WV(2); P8_BAR; P8_WL(0); P8_MMA(0, 0, At, B0); P8_BAR;
    P8_LDB(B1, 1, 1); P8_WV(0); P8_BAR; P8_WL(0); P8_MMA(0, 1, At, B1); P8_BAR;
    P8_LDA(At, 1, 1); P8_BAR; P8_WL(0); P8_MMA(1, 0, At, B0); P8_MMA(1, 1, At, B1); P8_BAR; }
  if (wr == 0) P8_BAR;
  __syncthreads();
}

__device__ __forceinline__ void tile_map(int v, int nM, int nN, int& pm, int& pn) {
  int nig = 8 * nN, gid = v / nig, fm = gid * 8, gsz = min(nM - fm, 8);
  pm = fm + (v % nig) % gsz; pn = (v % nig) / gsz;
}
__device__ __forceinline__ int block_lin(const P& p) {
  const int b = BIDX(), G = GRIDX();
  return (b & 7) * (G >> 3) + (b >> 3);
}

struct MTile { int base, L, ts, lo, hi; };
__device__ __forceinline__ MTile mtile_conv(int mt) {
  MTile t;
  if (mt < 32) { t.base = mt * 256; t.L = 256; t.ts = 0; t.lo = 0; t.hi = 256; }
  else { int lt = mt - 32, s = lt / 17, j = lt % 17; t.base = NCTX + s * 4096; t.L = 4096; t.ts = 254 * j - 1; t.lo = 1; t.hi = min(255, 4096 - t.ts); }
  return t;
}
__device__ __forceinline__ int mt_grow(const MTile& t, int lr) { return t.base + min(max(t.ts + lr, 0), t.L - 1); }
__device__ __forceinline__ bool mt_valid(const MTile& t, int lr) { int q = t.ts + lr; return lr >= 0 && lr < 256 && q >= 0 && q < t.L; }

__device__ __forceinline__ void ct_load8(int lr, int colbyte, float (&o)[8]) { unpack8(*(const u32x4*)(g_shm + lr * 544 + colbyte), o); }
__device__ __forceinline__ void ct_load8z(const MTile& t, int lr, int colbyte, float (&o)[8]) {
  if (mt_valid(t, lr)) ct_load8(lr, colbyte, o);
  else {
#pragma unroll
    for (int e = 0; e < 8; ++e) o[e] = 0.f;
  }
}

__device__ __forceinline__ void gemm_inproj(const P& p) {
  const bf16_t* A = (const bf16_t*)(p.ws + OFF_R1); const bf16_t* B = (const bf16_t*)(p.ws + OFF_WIN);
  bf16_t* Q = (bf16_t*)(p.ws + OFF_Q); bf16_t* K = (bf16_t*)(p.ws + OFF_K); bf16_t* V = (bf16_t*)(p.ws + OFF_V);
  bf16_t* GS = (bf16_t*)(p.ws + OFF_GS); bf16_t* CAT = (bf16_t*)(p.ws + OFF_CAT);
  const int nM = 100, nN = 14, G = GRIDX(), lin = block_lin(p);
  for (int v = lin; v < nM * nN; v += G) {
    const int tid = opaque_tid();
    int sR[4], sC[4];
    { const int wid = tid >> 6, lane = tid & 63;
#pragma unroll
      for (int i = 0; i < 4; ++i) stage_rc(wid * 1024 + i * 8192 + lane * 16, sR[i], sC[i]); }
    int pm, pn; tile_map(v, nM, nN, pm, pn);
    const MTile mt = mtile_conv(pm);
    u32 voffA[2], voffB[2];
#pragma unroll
    for (int i = 0; i < 2; ++i) { voffA[i] = (u32)(sR[i] * 1024 + sC[i]) * 2u; voffB[i] = voffA[i]; }
    f32x4 acc[2][2][4][2];
    gemm_tile8p(acc, A + (long)(mt.base + mt.ts) * 1024, (size_t)128 * 1024, voffA, B + (size_t)pn * 256 * 1024, (size_t)128 * 1024, voffB, 16, tid);
    asm volatile("" ::: "memory");
    const int tide = opaque_tid();
    const int wid = tide >> 6, lane = tide & 63, wr = wid >> 2, wc = wid & 3, fr = lane & 15, fq = lane >> 4; (void)wid; (void)lane;
#pragma unroll
    for (int ai = 0; ai < 2; ++ai)
#pragma unroll
      for (int bj = 0; bj < 2; ++bj)
#pragma unroll
        for (int m = 0; m < 4; ++m)
#pragma unroll
          for (int n = 0; n < 2; ++n) {
            const f32x4 a = acc[ai][bj][m][n];
            u32x2 o; o[0] = pk_bf16(a[0], a[1]); o[1] = pk_bf16(a[2], a[3]);
            *(u32x2*)(g_shm + (ai * 128 + wr * 64 + m * 16 + fr) * 544 + (bj * 128 + wc * 32 + n * 16 + fq * 4) * 2) = o;
          }
    __syncthreads();
    if (pn < 6) {
      const int cc = tide & 31, rg = tide >> 5, lr0 = rg * 16;
      float w0[8], w1[8], w2[8];
#pragma unroll
      for (int e = 0; e < 8; ++e) { int col = pn * 256 + cc * 8 + e; w0[e] = p.conv_qkv[col]; w1[e] = p.conv_qkv[1536 + col]; w2[e] = p.conv_qkv[3072 + col]; }
      bf16_t* dst = pn < 2 ? Q : pn < 4 ? K : V;
      const int dcol = (pn & 1) * 256 + cc * 8;
      const float post = pn < 2 ? 0.08838834764831845f : 1.f;
      float prev[8], cur[8], nxt[8];
      ct_load8z(mt, lr0 - 1, cc * 16, prev); ct_load8z(mt, lr0, cc * 16, cur);
#pragma unroll 4
      for (int i = 0; i < 16; ++i) {
        const int lr = lr0 + i;
        ct_load8z(mt, lr + 1, cc * 16, nxt);
        float o[8]; float ss = 0.f;
#pragma unroll
        for (int e = 0; e < 8; ++e) { float u = w0[e] * prev[e] + w1[e] * cur[e] + w2[e] * nxt[e]; o[e] = silu_f(u); ss += o[e] * o[e]; }
        if (pn < 4) {
          ss = sum16(ss);
          const float sc = rsqrtf(ss + EPSF) * post;
#pragma unroll
          for (int e = 0; e < 8; ++e) o[e] *= sc;
        }
        if (lr >= mt.lo && lr < mt.hi) *(u32x4*)(dst + (size_t)mt_grow(mt, lr) * 512 + dcol) = pack8(o);
#pragma unroll
        for (int e = 0; e < 8; ++e) { prev[e] = cur[e]; cur[e] = nxt[e]; }
      }
    } else {
      const int mm = pn - 6, cc = tide & 7, rg = tide >> 3, lr0 = rg * 4;
      float w0[8], w1[8], w2[8];
#pragma unroll
      for (int e = 0; e < 8; ++e) { int col = mm * 64 + cc * 8 + e; w0[e] = p.conv_b[col]; w1[e] = p.conv_b[512 + col]; w2[e] = p.conv_b[1024 + col]; }
      float prev[8], cur[8], nxt[8], t1[8], t2[8];
      ct_load8z(mt, lr0 - 1, 128 + cc * 16, t1); ct_load8z(mt, lr0 - 1, 256 + cc * 16, t2);
#pragma unroll
      for (int e = 0; e < 8; ++e) prev[e] = t1[e] * t2[e];
      ct_load8z(mt, lr0, 128 + cc * 16, t1); ct_load8z(mt, lr0, 256 + cc * 16, t2);
#pragma unroll
      for (int e = 0; e < 8; ++e) cur[e] = t1[e] * t2[e];
#pragma unroll
      for (int i = 0; i < 4; ++i) {
        const int lr = lr0 + i;
        ct_load8z(mt, lr + 1, 128 + cc * 16, t1); ct_load8z(mt, lr + 1, 256 + cc * 16, t2);
#pragma unroll
        for (int e = 0; e < 8; ++e) nxt[e] = t1[e] * t2[e];
        if (lr >= mt.lo && lr < mt.hi) {
          float bg[8], gt[8], o[8], o2[8];
          ct_load8(lr, cc * 16, bg); ct_load8(lr, 384 + cc * 16, gt);
#pragma unroll
          for (int e = 0; e < 8; ++e) { o[e] = bg[e] * (w0[e] * prev[e] + w1[e] * cur[e] + w2[e] * nxt[e]); o2[e] = silu_f(gt[e]); }
          const size_t grow = (size_t)mt_grow(mt, lr);
          *(u32x4*)(CAT + grow * 1024 + 512 + mm * 64 + cc * 8) = pack8(o);
          *(u32x4*)(GS + grow * 512 + mm * 64 + cc * 8) = pack8(o2);
        }
#pragma unroll
        for (int e = 0; e < 8; ++e) { prev[e] = cur[e]; cur[e] = nxt[e]; }
      }
    }
    __syncthreads();
  }
}

__device__ __forceinline__ void gemm_ffn_gu(const P& p, int layer, const bf16_t* A) {
  const bf16_t* B = (const bf16_t*)(p.ws + OFF_WGU) + (size_t)layer * 5632 * 1024;
  bf16_t* ACT = (bf16_t*)(p.ws + OFF_ACT);
  const float* rsq = (const float*)(p.ws + OFF_RSQ);
  const float* sW = (const float*)(p.ws + OFF_SW);
  const float* cw = p.ffn_conv + (size_t)layer * 3 * 2816;
  const int nM = 100, nN = 22, G = GRIDX(), lin = block_lin(p);
  for (int v = lin; v < nM * nN; v += G) {
    const int tid = opaque_tid();
    int sR[4], sC[4];
    { const int wid = tid >> 6, lane = tid & 63;
#pragma unroll
      for (int i = 0; i < 4; ++i) stage_rc(wid * 1024 + i * 8192 + lane * 16, sR[i], sC[i]); }
    int pm, pn; tile_map(v, nM, nN, pm, pn);
    const MTile mt = mtile_conv(pm);
    u32 voffA[2], voffB[2];
#pragma unroll
    for (int i = 0; i < 2; ++i) { voffA[i] = (u32)(sR[i] * 1024 + sC[i]) * 2u; voffB[i] = voffA[i]; }
    f32x4 acc[2][2][4][2];
    gemm_tile8p(acc, A + (long)(mt.base + mt.ts) * 1024, (size_t)128 * 1024, voffA, B + (size_t)pn * 256 * 1024, (size_t)128 * 1024, voffB, 16, tid);
    asm volatile("" ::: "memory");
    const int tide = opaque_tid();
    const int wid = tide >> 6, lane = tide & 63, wr = wid >> 2, wc = wid & 3, fr = lane & 15, fq = lane >> 4; (void)wid; (void)lane;
    const int cond = row_cond(mt.base);
    const float* sWc = sW + ((size_t)layer * 5 + cond) * 5632 + pn * 256 + wc * 32 + fq * 4;
    f32x4 s4[2][2];
#pragma unroll
    for (int bj = 0; bj < 2; ++bj)
#pragma unroll
      for (int n = 0; n < 2; ++n) s4[bj][n] = *(const f32x4*)(sWc + bj * 128 + n * 16);
#pragma unroll
    for (int ai = 0; ai < 2; ++ai)
#pragma unroll
      for (int m = 0; m < 4; ++m) {
        const int lr = ai * 128 + wr * 64 + m * 16 + fr, g = mt_grow(mt, lr);
        const float rinv = rsqrtf((rsq[g] + rsq[NTOK + g] + rsq[2 * NTOK + g] + rsq[3 * NTOK + g]) * (1.f / 1024.f) + EPSF);
#pragma unroll
        for (int bj = 0; bj < 2; ++bj)
#pragma unroll
          for (int n = 0; n < 2; ++n) {
            f32x4 t = acc[ai][bj][m][n] * rinv + s4[bj][n];
            u32x2 o; o[0] = pk_bf16(t[0], t[1]); o[1] = pk_bf16(t[2], t[3]);
            *(u32x2*)(g_shm + lr * 544 + (bj * 128 + wc * 32 + n * 16 + fq * 4) * 2) = o;
          }
        asm volatile("" ::: "memory");
      }
    __syncthreads();
    {
      const int cc = tide & 15, rg = tide >> 4, lr0 = rg * 8;
      float w0[8], w1[8], w2[8];
#pragma unroll
      for (int e = 0; e < 8; ++e) { int col = pn * 128 + cc * 8 + e; w0[e] = cw[col]; w1[e] = cw[2816 + col]; w2[e] = cw[2 * 2816 + col]; }
      float prev[8], cur[8], nxt[8];
      ct_load8z(mt, lr0 - 1, cc * 16, prev); ct_load8z(mt, lr0, cc * 16, cur);
#pragma unroll 4
      for (int i = 0; i < 8; ++i) {
        const int lr = lr0 + i;
        ct_load8z(mt, lr + 1, cc * 16, nxt);
        if (lr >= mt.lo && lr < mt.hi) {
          float up[8], o[8];
          ct_load8(lr, 256 + cc * 16, up);
#pragma unroll
          for (int e = 0; e < 8; ++e) { float u = w0[e] * prev[e] + w1[e] * cur[e] + w2[e] * nxt[e]; o[e] = silu_f(u) * up[e]; }
          *(u32x4*)(ACT + (size_t)mt_grow(mt, lr) * 2816 + pn * 128 + cc * 8) = pack8(o);
        }
#pragma unroll
        for (int e = 0; e < 8; ++e) { prev[e] = cur[e]; cur[e] = nxt[e]; }
      }
    }
    __syncthreads();
  }
}

__device__ __forceinline__ void gemm_resid(const P& p, int mode, int layer, const bf16_t* A, int lda, const bf16_t* Bw, int ldb, int nk, bf16_t* A2) {
  const float* mod = (const float*)(p.ws + OFF_MOD);
  float* rsq = (float*)(p.ws + OFF_RSQ);
  const bf16_t* X = (const bf16_t*)p.out;
  bf16_t* Xout = (mode == 1 && layer == 1) ? (bf16_t*)(p.ws + OFF_R1) : (bf16_t*)p.out;
  const int nM = 96, nN = 4, G = GRIDX(), lin = block_lin(p);
  const int ntiles = nM * nN, nfull = (ntiles / G) * G, nrem = ntiles - nfull;
  const bool split = nrem > 0 && 2 * nrem <= G;
  auto epi_rows = [&](int pn, size_t growbase, const float* mc, int wid, int lane) {
    const int ccol = pn * 256 + lane * 4;
    const f32x4 gvn = *(const f32x4*)(mc + (mode == 1 ? 5 : 2) * 1024 + ccol);
    f32x4 gsn = gvn, csn = gvn;
    if (mode != 1) { f32x4 ng = *(const f32x4*)(p.norm_ffn_g + layer * 1024 + ccol), sc = *(const f32x4*)(mc + 4 * 1024 + ccol); gsn = ng * (sc + 1.f); }
    if (mode == 2) csn = *(const f32x4*)(p.pool_scale + ccol);
    u32x2 xrow[16];
#pragma unroll
    for (int r = 0; r < 16; ++r) xrow[r] = *(const u32x2*)(X + (growbase + wid * 16 + r) * 1024 + ccol);
#pragma unroll
    for (int r = 0; r < 16; ++r) {
      const int lrow = wid * 16 + r; const size_t grow = growbase + lrow;
      f32x4 y = *(const f32x4*)(g_shm + lrow * 1088 + lane * 16);
      if (mode == 2) y = y * csn;
      const u32x2 xr = xrow[r];
      f32x4 x = (f32x4){bf_lo(xr[0]), bf_hi(xr[0]), bf_lo(xr[1]), bf_hi(xr[1])};
      x = x + gvn * y;
      { u32x2 xo; xo[0] = pk_bf16(x[0], x[1]); xo[1] = pk_bf16(x[2], x[3]); *(u32x2*)(Xout + grow * 1024 + ccol) = xo; }
      if (mode != 1) { f32x4 a = x * gsn; u32x2 o; o[0] = pk_bf16(a[0], a[1]); o[1] = pk_bf16(a[2], a[3]); *(u32x2*)(A2 + grow * 1024 + ccol) = o; }
      const float ss = wave_sum(x[0] * x[0] + x[1] * x[1] + x[2] * x[2] + x[3] * x[3]);
      if (lane == 0) rsq[(size_t)pn * NTOK + grow] = ss;
    }
  };
  for (int v = lin;; v += G) {
    const int tid = opaque_tid();
    int sR[4], sC[4];
    { const int wid = tid >> 6, lane = tid & 63;
#pragma unroll
      for (int i = 0; i < 4; ++i) stage_rc(wid * 1024 + i * 8192 + lane * 16, sR[i], sC[i]); }
    int tile, mh = -1;
    if (!split || v < nfull) { if (v >= ntiles) break; tile = v; }
    else { const int u = v - nfull; if (u >= 2 * nrem) break; tile = nfull + (u >> 1); mh = u & 1; }
    int pm, pn; tile_map(tile, nM, nN, pm, pn);
    const float* mc = mod + ((size_t)layer * 5 + row_cond(pm * 256)) * 6144;
    if (mh < 0) {
      u32 voffA[2], voffB[2];
#pragma unroll
      for (int i = 0; i < 2; ++i) { voffA[i] = (u32)(sR[i] * lda + sC[i]) * 2u; voffB[i] = (u32)(sR[i] * ldb + sC[i]) * 2u; }
      f32x4 acc[2][2][4][2];
      gemm_tile8p(acc, A + (size_t)pm * 256 * lda + (mode == 2 ? pn * 256 : 0), (size_t)128 * lda, voffA,
                  Bw + (mode == 2 ? (size_t)pn * 65536 : (size_t)pn * 256 * ldb), (size_t)128 * ldb, voffB, nk, tid);
      asm volatile("" ::: "memory");
    const int tide = opaque_tid();
    const int wid = tide >> 6, lane = tide & 63, wr = wid >> 2, wc = wid & 3, fr = lane & 15, fq = lane >> 4; (void)wid; (void)lane;
#pragma unroll
      for (int hf = 0; hf < 2; ++hf) {
#pragma unroll
        for (int bj = 0; bj < 2; ++bj)
#pragma unroll
          for (int m = 0; m < 4; ++m)
#pragma unroll
            for (int n = 0; n < 2; ++n) *(f32x4*)(g_shm + (wr * 64 + m * 16 + fr) * 1088 + (bj * 128 + wc * 32 + n * 16 + fq * 4) * 4) = acc[hf][bj][m][n];
        __syncthreads();
        epi_rows(pn, (size_t)pm * 256 + hf * 128, mc, wid, lane);
        __syncthreads();
      }
    } else {
      u32 aoff[4], boff[4];
#pragma unroll
      for (int i = 0; i < 4; ++i) {
        aoff[i] = (u32)(pm * 256 + (mh > 0 ? 128 : 0) + sR[i]) * (u32)lda + sC[i] + (mode == 2 ? pn * 256 : 0);
        boff[i] = (mode == 2 ? (u32)pn * 65536u + (u32)sR[i] * 256u : (u32)(pn * 256 + sR[i]) * (u32)ldb) + sC[i];
      }
      f32x4 acc[4][4];
      gemm_tile<4>(acc, A, aoff, Bw, boff, nk, tid);
      asm volatile("" ::: "memory");
    const int tide = opaque_tid();
    const int wid = tide >> 6, lane = tide & 63, wr = wid >> 2, wc = wid & 3, fr = lane & 15, fq = lane >> 4; (void)wid; (void)lane;
#pragma unroll
      for (int m = 0; m < 4; ++m)
#pragma unroll
        for (int n = 0; n < 4; ++n) *(f32x4*)(g_shm + (wr * 64 + m * 16 + fr) * 1088 + (wc * 64 + n * 16 + fq * 4) * 4) = acc[m][n];
      __syncthreads();
      epi_rows(pn, (size_t)pm * 256 + mh * 128, mc, wid, lane);
      __syncthreads();
    }
  }
}

template <bool REV>
__device__ __forceinline__ void tri_solve(const float* Mp, float* Tl, int lane, bf16_t* Tg) {
  auto Mrow4 = [&](int i, int j) -> f32x4 {
    if (REV) { const f32x4 v = *(const f32x4*)(Mp + (63 - i) * 64 + 60 - j); return (f32x4){v[3], v[2], v[1], v[0]}; }
    return *(const f32x4*)(Mp + i * 64 + j);
  };
  auto M1 = [&](int i, int j) -> float { return REV ? Mp[(63 - i) * 64 + (63 - j)] : Mp[i * 64 + j]; };
  for (int g = 0; g < 16; ++g) {
    const int i0 = 4 * g;
    float a0 = (i0 == lane) ? 1.f : 0.f, a1 = (i0 + 1 == lane) ? 1.f : 0.f, a2 = (i0 + 2 == lane) ? 1.f : 0.f, a3 = (i0 + 3 == lane) ? 1.f : 0.f;
#pragma unroll 2
    for (int j = 0; j < i0; j += 4) {
      const float t0 = Tl[j * 64 + lane], t1 = Tl[(j + 1) * 64 + lane], t2 = Tl[(j + 2) * 64 + lane], t3 = Tl[(j + 3) * 64 + lane];
      const f32x4 m0 = Mrow4(i0, j), m1 = Mrow4(i0 + 1, j), m2 = Mrow4(i0 + 2, j), m3 = Mrow4(i0 + 3, j);
      a0 -= (m0[0] * t0 + m0[1] * t1) + (m0[2] * t2 + m0[3] * t3);
      a1 -= (m1[0] * t0 + m1[1] * t1) + (m1[2] * t2 + m1[3] * t3);
      a2 -= (m2[0] * t0 + m2[1] * t1) + (m2[2] * t2 + m2[3] * t3);
      a3 -= (m3[0] * t0 + m3[1] * t1) + (m3[2] * t2 + m3[3] * t3);
    }
    const float T0 = a0;
    const float T1 = a1 - M1(i0 + 1, i0) * T0;
    const float T2 = a2 - (M1(i0 + 2, i0) * T0 + M1(i0 + 2, i0 + 1) * T1);
    const float T3 = a3 - (M1(i0 + 3, i0) * T0 + M1(i0 + 3, i0 + 1) * T1 + M1(i0 + 3, i0 + 2) * T2);
    Tl[i0 * 64 + lane] = T0; Tl[(i0 + 1) * 64 + lane] = T1; Tl[(i0 + 2) * 64 + lane] = T2; Tl[(i0 + 3) * 64 + lane] = T3;
    const float tv[4] = {T0, T1, T2, T3};
#pragma unroll
    for (int r = 0; r < 4; ++r) {
      const int i = i0 + r;
      const bf16_t v = (bf16_t)(pk_bf16(tv[r], 0.f) & 0xffffu);
      if (REV) { if (i > lane) Tg[(63 - i) * 64 + (63 - lane)] = v; }
      else { if (i >= lane) Tg[i * 64 + lane] = v; }
    }
  }
}

__device__ __forceinline__ void phase3(const P& p) {
  const int tid = opaque_tid(), sub = tid >> 8, t = tid & 255, w = t >> 6, lane = tid & 63, fr = lane & 15, fq = lane >> 4;
  char* sm = g_shm + sub * 69632;
  char* sk = sm;
  char* sq = sm + 17408;
  float* KK = (float*)(sm + 34816);
  float* QK = (float*)(sm + 51200);
  float* sc = (float*)(sm + 67584);
  const bf16_t* Q = (const bf16_t*)(p.ws + OFF_Q); const bf16_t* K = (const bf16_t*)(p.ws + OFF_K);
  const float* gb = (const float*)(p.ws + OFF_G); const float* bb = (const float*)(p.ws + OFF_BETA);
  bf16_t* Tp = (bf16_t*)(p.ws + OFF_TP); bf16_t* Ap = (bf16_t*)(p.ws + OFF_AP);
  u32x4 pk[4], pq[4];
  auto issue = [&](int it_) {
    const int item_ = it_ * 2 + sub, row0_ = (item_ >> 2) * 64, h_ = item_ & 3;
#pragma unroll
    for (int i = 0; i < 4; ++i) {
      int idx = t + 256 * i, r = idx >> 4, cc = idx & 15;
      pk[i] = *(const u32x4*)(K + (size_t)(row0_ + r) * 512 + h_ * 128 + cc * 8);
      pq[i] = *(const u32x4*)(Q + (size_t)(row0_ + r) * 512 + h_ * 128 + cc * 8);
    }
  };
  if (BIDX() < 768) issue(BIDX());
  for (int it = BIDX(); it < 768; it += GRIDX()) {
    const int item = it * 2 + sub, ch = item >> 2, h = item & 3, row0 = ch * 64;
#pragma unroll
    for (int i = 0; i < 4; ++i) {
      int idx = t + 256 * i, r = idx >> 4, cc = idx & 15;
      *(u32x4*)(sk + r * 272 + cc * 16) = pk[i];
      *(u32x4*)(sq + r * 272 + cc * 16) = pq[i];
    }
    if (t < 64) {
      float g = gb[(size_t)(row0 + t) * 8 + h];
g = wave_prefix(g, lane);
      sc[t] = g; sc[128 + t] = bb[(size_t)(row0 + t) * 8 + h];
    } else if (t < 128) {
      const int i = 63 - lane;
      float g = gb[(size_t)(row0 + i) * 8 + 4 + h];
g = wave_prefix(g, lane);
      sc[64 + i] = g; sc[192 + i] = bb[(size_t)(row0 + i) * 8 + 4 + h];
    }
    __syncthreads();
    {
      f32x4 a1[4], a2[4];
#pragma unroll
      for (int n = 0; n < 4; ++n) { a1[n] = (f32x4){0.f, 0.f, 0.f, 0.f}; a2[n] = a1[n]; }
#pragma unroll
      for (int ks = 0; ks < 4; ++ks) {
        bf16x8 ak = *(const bf16x8*)(sk + (16 * w + fr) * 272 + (ks * 32 + fq * 8) * 2);
        bf16x8 aq = *(const bf16x8*)(sq + (16 * w + fr) * 272 + (ks * 32 + fq * 8) * 2);
#pragma unroll
        for (int n = 0; n < 4; ++n) {
          bf16x8 b = *(const bf16x8*)(sk + (16 * n + fr) * 272 + (ks * 32 + fq * 8) * 2);
          a1[n] = __builtin_amdgcn_mfma_f32_16x16x32_bf16(ak, b, a1[n], 0, 0, 0);
          a2[n] = __builtin_amdgcn_mfma_f32_16x16x32_bf16(aq, b, a2[n], 0, 0, 0);
        }
      }
#pragma unroll
      for (int n = 0; n < 4; ++n)
#pragma unroll
        for (int j = 0; j < 4; ++j) {
          const int c = 16 * w + fq * 4 + j, s = 16 * n + fr;
          float mval, aval;
          if (s < c) { float d = __expf(sc[c] - sc[s]); mval = sc[128 + c] * a1[n][j] * d; aval = a2[n][j] * d; }
          else if (s > c) { float d = __expf(sc[64 + c] - sc[64 + s]); mval = sc[192 + c] * a1[n][j] * d; aval = a2[n][j] * d; }
          else { mval = 0.f; aval = a2[n][j]; }
          KK[c * 64 + s] = mval; QK[c * 64 + s] = aval;
        }
    }
    __syncthreads();
    if (it + GRIDX() < 768) issue(it + GRIDX());
    const int role = sub ? (w ^ 2) : w;
    if (role == 0) tri_solve<false>(KK, (float*)sk, lane, Tp + (size_t)item * 4096);
    else if (role == 1) tri_solve<true>(KK, (float*)sk + 4096, lane, Tp + (size_t)item * 4096);
    else {
      const int u = sub ? t : t - 128;
#pragma unroll
      for (int i = 0; i < 4; ++i) {
        int idx = u + 128 * i; float o[8];
#pragma unroll
        for (int e = 0; e < 8; ++e) o[e] = QK[idx * 8 + e];
        *(u32x4*)(Ap + (size_t)item * 4096 + idx * 8) = pack8(o);
      }
    }
    __syncthreads();
  }
}

constexpr int S_KT = 0, S_VT = 36864, S_ST = 46080, S_RT = 54784, S_VN = 59392, S_VNS = 64000, S_OT = 68608, S_SC = 78848;
constexpr int D_KT = 18432, D_VT = 4608, D_OT = 5120, D_SC = 1024;

__device__ __forceinline__ u32x4 mask_frag(u32x4 v, int r, int c0, int dir, bool unit_diag) {
#pragma unroll
  for (int e = 0; e < 4; ++e) {
    const int ca = c0 + 2 * e, cb = ca + 1;
    u32 lo = v[e] & 0xffffu, hi = v[e] >> 16;
    const bool ka = dir ? (ca > r) : (ca < r), kb = dir ? (cb > r) : (cb < r);
    if (!ka) lo = (ca == r) ? (unit_diag ? 0x3f80u : lo) : 0u;
    if (!kb) hi = (cb == r) ? (unit_diag ? 0x3f80u : hi) : 0u;
    v[e] = lo | (hi << 16);
  }
  return v;
}

__device__ __forceinline__ void scan_item(const P& p, int item) {
  const int tid = opaque_tid(), w = tid >> 6, lane = tid & 63, fr = lane & 15, fq = lane >> 4;
  int seqbase, nchunk, sidx, rem; bool lat;
  if (item < 128) { lat = true; sidx = item >> 5; rem = item & 31; seqbase = NCTX + sidx * 4096; nchunk = 64; }
  else { lat = false; const int u = item - 128; sidx = u >> 5; rem = u & 31; seqbase = sidx * 256; nchunk = 4; }
  const int h = rem >> 3, dir = (rem >> 2) & 1, q4 = rem & 3, dvoff = h * 128 + q4 * 32;
  const bf16_t* Q = (const bf16_t*)(p.ws + OFF_Q); const bf16_t* K = (const bf16_t*)(p.ws + OFF_K); const bf16_t* V = (const bf16_t*)(p.ws + OFF_V);
  const float* gb = (const float*)(p.ws + OFF_G); const float* bb = (const float*)(p.ws + OFF_BETA);
  const bf16_t* Tp = (const bf16_t*)(p.ws + OFF_TP); const bf16_t* Ap = (const bf16_t*)(p.ws + OFF_AP);
  bf16_t* obuf = dir == 0 ? (bf16_t*)(p.ws + OFF_CAT) : (bf16_t*)(p.ws + OFF_OB);
  const int old_ = dir == 0 ? 1024 : 512;
  f32x4 S[2];
  if (lat) {
    const float* s0 = p.state + (((size_t)sidx * 2 + dir) * 4 + h) * 16384;
#pragma unroll
    for (int n = 0; n < 2; ++n)
#pragma unroll
      for (int j = 0; j < 4; ++j) S[n][j] = s0[(16 * w + fq * 4 + j) * 128 + q4 * 32 + n * 16 + fr];
  } else {
#pragma unroll
    for (int n = 0; n < 2; ++n) S[n] = (f32x4){0.f, 0.f, 0.f, 0.f};
  }
#pragma unroll
  for (int n = 0; n < 2; ++n) {
    u32x2 o; o[0] = pk_bf16(S[n][0], S[n][1]); o[1] = pk_bf16(S[n][2], S[n][3]);
    *(u32x2*)(g_shm + S_ST + (n * 16 + fr) * 272 + (16 * w + fq * 4) * 2) = o;
  }
  struct PF {
    u32x4 na[4], nt[2], nat[2];
    u32x4 pk[2], pv;
    float pg, pb;
  };
  PF R0, R1;
  R0.pg = R0.pb = R1.pg = R1.pb = 0.f;
  const int arow = 16 * (w & 3) + fr;
  auto issue_loads = [&](PF& r, int cidx) {
    const int row0 = seqbase + cidx * 64; const size_t pit = ((size_t)(row0 >> 6) * 4 + h) * 4096;
    const bf16_t* ab = (w < 4 ? K : Q) + (size_t)(row0 + arow) * 512 + h * 128 + fq * 8;
#pragma unroll
    for (int ks = 0; ks < 4; ++ks) r.na[ks] = *(const u32x4*)(ab + ks * 32);
#pragma unroll
    for (int ks = 0; ks < 2; ++ks) { r.nt[ks] = *(const u32x4*)(Tp + pit + arow * 64 + ks * 32 + fq * 8); r.nat[ks] = *(const u32x4*)(Ap + pit + arow * 64 + ks * 32 + fq * 8); }
#pragma unroll
    for (int i = 0; i < 2; ++i) r.pk[i] = *(const u32x4*)(K + (size_t)(row0 + lane) * 512 + h * 128 + (w + 8 * i) * 8);
    r.pv = *(const u32x4*)(V + (size_t)(row0 + lane) * 512 + dvoff + (w & 3) * 8);
    { int i = dir ? 63 - lane : lane; r.pg = gb[(size_t)(row0 + i) * 8 + dir * 4 + h]; r.pb = bb[(size_t)(row0 + i) * 8 + dir * 4 + h]; }
  };
  auto store_tiles = [&](const PF& r, int buf) {
    float* scl = (float*)(g_shm + S_SC + buf * D_SC);
#pragma unroll
    for (int i = 0; i < 2; ++i) {
      const int cc = w + 8 * i;
#pragma unroll
      for (int e = 0; e < 4; ++e) {
        *(bf16_t*)(g_shm + S_KT + buf * D_KT + (cc * 8 + 2 * e) * 144 + lane * 2) = (bf16_t)(r.pk[i][e] & 0xffffu);
        *(bf16_t*)(g_shm + S_KT + buf * D_KT + (cc * 8 + 2 * e + 1) * 144 + lane * 2) = (bf16_t)(r.pk[i][e] >> 16);
      }
    }
    if (w < 4) {
#pragma unroll
      for (int e = 0; e < 4; ++e) {
        *(bf16_t*)(g_shm + S_VT + buf * D_VT + (w * 8 + 2 * e) * 144 + lane * 2) = (bf16_t)(r.pv[e] & 0xffffu);
        *(bf16_t*)(g_shm + S_VT + buf * D_VT + (w * 8 + 2 * e + 1) * 144 + lane * 2) = (bf16_t)(r.pv[e] >> 16);
      }
    }
    if (tid < 64) {
      float g = wave_prefix(r.pg, lane);
      const float tot = rdlane(g, 63);
      const int i = dir ? 63 - lane : lane;
      scl[i] = __expf(g); scl[64 + i] = __expf(tot - g); scl[128 + i] = r.pb;
      if (lane == 0) scl[192] = __expf(tot);
    }
  };
  issue_loads(R0, dir ? nchunk - 1 : 0);
  issue_loads(R1, dir ? nchunk - 2 : 1);
  store_tiles(R0, 0);
  __syncthreads();
  auto step = [&](const int st, PF& mine, PF& other) {
    const int cidx = dir ? nchunk - 1 - st : st;
    const int row0 = seqbase + cidx * 64, buf = st & 1;
    const float* scl = (const float*)(g_shm + S_SC + buf * D_SC);
    bf16x8 ca[4], ct[2], cat[2];
#pragma unroll
    for (int ks = 0; ks < 4; ++ks) ca[ks] = __builtin_bit_cast(bf16x8, mine.na[ks]);
#pragma unroll
    for (int ks = 0; ks < 2; ++ks) {
      ct[ks] = __builtin_bit_cast(bf16x8, mask_frag(mine.nt[ks], arow, ks * 32 + fq * 8, dir, true));
      cat[ks] = __builtin_bit_cast(bf16x8, mask_frag(mine.nat[ks], arow, ks * 32 + fq * 8, dir, false));
    }
    issue_loads(mine, dir ? max(cidx - 2, 0) : min(cidx + 2, nchunk - 1));
    f32x4 a1[2];
#pragma unroll
    for (int n = 0; n < 2; ++n) a1[n] = (f32x4){0.f, 0.f, 0.f, 0.f};
#pragma unroll
    for (int ks = 0; ks < 4; ++ks)
#pragma unroll
      for (int n = 0; n < 2; ++n) {
        bf16x8 b = *(const bf16x8*)(g_shm + S_ST + (16 * n + fr) * 272 + (ks * 32 + fq * 8) * 2);
        a1[n] = __builtin_amdgcn_mfma_f32_16x16x32_bf16(ca[ks], b, a1[n], 0, 0, 0);
      }
    if (w < 4) {
      const int t0 = 16 * w + fq * 4;
      const f32x4 eg = *(const f32x4*)(scl + t0), be = *(const f32x4*)(scl + 128 + t0);
#pragma unroll
      for (int n = 0; n < 2; ++n) {
        u32x2 vv = *(const u32x2*)(g_shm + S_VT + buf * D_VT + (n * 16 + fr) * 144 + t0 * 2);
        float r0 = be[0] * (bf_lo(vv[0]) - eg[0] * a1[n][0]), r1 = be[1] * (bf_hi(vv[0]) - eg[1] * a1[n][1]);
        float r2 = be[2] * (bf_lo(vv[1]) - eg[2] * a1[n][2]), r3 = be[3] * (bf_hi(vv[1]) - eg[3] * a1[n][3]);
        u32x2 o; o[0] = pk_bf16(r0, r1); o[1] = pk_bf16(r2, r3);
        *(u32x2*)(g_shm + S_RT + (n * 16 + fr) * 144 + t0 * 2) = o;
      }
    }
    __syncthreads();
    {
      const int mt = w & 3, nn = w >> 2, t0 = mt * 16 + fq * 4;
      f32x4 vn = (f32x4){0.f, 0.f, 0.f, 0.f};
#pragma unroll
      for (int ks = 0; ks < 2; ++ks) {
        bf16x8 b = *(const bf16x8*)(g_shm + S_RT + (nn * 16 + fr) * 144 + (ks * 32 + fq * 8) * 2);
        vn = __builtin_amdgcn_mfma_f32_16x16x32_bf16(ct[ks], b, vn, 0, 0, 0);
      }
      const f32x4 el = *(const f32x4*)(scl + 64 + t0);
      u32x2 o; o[0] = pk_bf16(vn[0], vn[1]); o[1] = pk_bf16(vn[2], vn[3]);
      *(u32x2*)(g_shm + S_VN + (nn * 16 + fr) * 144 + t0 * 2) = o;
      u32x2 o2; o2[0] = pk_bf16(vn[0] * el[0], vn[1] * el[1]); o2[1] = pk_bf16(vn[2] * el[2], vn[3] * el[3]);
      *(u32x2*)(g_shm + S_VNS + (nn * 16 + fr) * 144 + t0 * 2) = o2;
    }
    __syncthreads();
    if (w >= 4) {
      const int t0 = (w - 4) * 16 + fq * 4;
      const f32x4 eg = *(const f32x4*)(scl + t0);
#pragma unroll
      for (int n = 0; n < 2; ++n) a1[n] = a1[n] * eg;
#pragma unroll
      for (int ks = 0; ks < 2; ++ks)
#pragma unroll
        for (int n = 0; n < 2; ++n) {
          bf16x8 b = *(const bf16x8*)(g_shm + S_VN + (n * 16 + fr) * 144 + (ks * 32 + fq * 8) * 2);
          a1[n] = __builtin_amdgcn_mfma_f32_16x16x32_bf16(cat[ks], b, a1[n], 0, 0, 0);
        }
#pragma unroll
      for (int n = 0; n < 2; ++n)
#pragma unroll
        for (int j = 0; j < 4; ++j)
          *(bf16_t*)(g_shm + S_OT + buf * D_OT + (t0 + j) * 80 + (n * 16 + fr) * 2) = (bf16_t)(pk_bf16(a1[n][j], 0.f) & 0xffffu);
    }
    {
      const float gl = scl[192];
#pragma unroll
      for (int n = 0; n < 2; ++n) S[n] = S[n] * gl;
#pragma unroll
      for (int ks = 0; ks < 2; ++ks) {
        bf16x8 a = *(const bf16x8*)(g_shm + S_KT + buf * D_KT + (16 * w + fr) * 144 + (ks * 32 + fq * 8) * 2);
#pragma unroll
        for (int n = 0; n < 2; ++n) {
          bf16x8 b = *(const bf16x8*)(g_shm + S_VNS + (n * 16 + fr) * 144 + (ks * 32 + fq * 8) * 2);
          S[n] = __builtin_amdgcn_mfma_f32_16x16x32_bf16(a, b, S[n], 0, 0, 0);
        }
      }
#pragma unroll
      for (int n = 0; n < 2; ++n) {
        u32x2 o; o[0] = pk_bf16(S[n][0], S[n][1]); o[1] = pk_bf16(S[n][2], S[n][3]);
        *(u32x2*)(g_shm + S_ST + (n * 16 + fr) * 272 + (16 * w + fq * 4) * 2) = o;
      }
    }
    if (st + 1 < nchunk) store_tiles(other, buf ^ 1);
    __syncthreads();
    __builtin_amdgcn_s_waitcnt(0x0F7D); __builtin_amdgcn_sched_barrier(0);
    if (tid < 256) { const int r = tid >> 2, cc = tid & 3;
      *(u32x4*)(obuf + (size_t)(row0 + r) * old_ + dvoff + cc * 8) = *(const u32x4*)(g_shm + S_OT + buf * D_OT + r * 80 + cc * 16); }
  };
  for (int st = 0; st < nchunk; st += 2) { step(st, R0, R1); step(st + 1, R1, R0); }
  __syncthreads();
  if (!lat) {
    float* dst = p.out + (size_t)NTOK * 1024 + (((size_t)sidx * 2 + dir) * 4 + h) * 16384;
#pragma unroll
    for (int n = 0; n < 2; ++n)
#pragma unroll
      for (int j = 0; j < 4; ++j) dst[(16 * w + fq * 4 + j) * 128 + q4 * 32 + n * 16 + fr] = S[n][j];
  }
}

__device__ __forceinline__ void phase4(const P& p) {
  const int b = BIDX(), G = GRIDX();
  if (G >= 256 && (G & 7) == 0) {
    const int x = b & 7, y = b >> 3;
    if (y < 16) scan_item(p, ((x * 4 + (y >> 2)) << 2) | (y & 3));
    else {
      const int ny = (G >> 3) - 16;
      for (int q = y - 16; q < 128; q += ny)
        scan_item(p, 128 + (((q >> 2) * 8 + x) << 2 | (q & 3)));
      cvt_loop(p, 1216 + (b - 128), 5440, G - 128, opaque_tid());
    }
  } else {
    for (int it = b; it < 128 + 1024; it += G) scan_item(p, it);
    cvt_loop(p, 1216 + b, 5440, G, opaque_tid());
  }
}

__device__ __forceinline__ void phase5(const P& p) {
  const int tid = opaque_tid();
  {
    const int lane = tid & 63, wid = tid >> 6;
    float* sh2 = (float*)g_shm;
    const float* mod = (const float*)(p.ws + OFF_MOD);
#pragma unroll 10
    for (int idx = tid; idx < 10240; idx += NTHREADS) { int lc = idx >> 10, k = idx & 1023; sh2[idx] = mod[(size_t)lc * 6144 + 3 * 1024 + k]; }
    __syncthreads();
    const bf16_t* Wgu = (const bf16_t*)(p.ws + OFF_WGU);
    float* sW = (float*)(p.ws + OFF_SW);
    for (int r = BIDX() * 8 + wid; r < 2 * 5632; r += GRIDX() * 8) {
      const int l = r / 5632, n = r % 5632;
      float a[5] = {0.f, 0.f, 0.f, 0.f, 0.f};
#pragma unroll
      for (int i = 0; i < 2; ++i) {
        const int k = i * 512 + lane * 8;
        float w[8]; unpack8(*(const u32x4*)(Wgu + ((size_t)l * 5632 + n) * 1024 + k), w);
#pragma unroll
        for (int c = 0; c < 5; ++c) {
          const float* s = sh2 + (l * 5 + c) * 1024 + k;
#pragma unroll
          for (int e = 0; e < 8; ++e) a[c] += w[e] * s[e];
        }
      }
#pragma unroll
      for (int c = 0; c < 5; ++c) { float v = wave_sum(a[c]); if (lane == 0) sW[((size_t)l * 5 + c) * 5632 + n] = v; }
    }
  }
  bf16_t* CAT = (bf16_t*)(p.ws + OFF_CAT); const bf16_t* OB = (const bf16_t*)(p.ws + OFF_OB); const bf16_t* GS = (const bf16_t*)(p.ws + OFF_GS);
  const int l16 = tid & 15, grp = tid >> 4;
  float gn[8];
#pragma unroll
  for (int e = 0; e < 8; ++e) gn[e] = p.o_norm_g[l16 * 8 + e];
  const int pstep = GRIDX() * 32;
  for (int pr = BIDX() * 32 + grp; pr < NTOK * 4; pr += 2 * pstep) {
    const int pr1 = pr + pstep; const bool has1 = pr1 < NTOK * 4; const int q1 = has1 ? pr1 : pr;
    const int row = pr >> 2, h = pr & 3, row1 = q1 >> 2, h1 = q1 & 3;
    const u32x4 la = *(const u32x4*)(CAT + (size_t)row * 1024 + h * 128 + l16 * 8), lb = *(const u32x4*)(OB + (size_t)row * 512 + h * 128 + l16 * 8), lg = *(const u32x4*)(GS + (size_t)row * 512 + h * 128 + l16 * 8);
    const u32x4 ma = *(const u32x4*)(CAT + (size_t)row1 * 1024 + h1 * 128 + l16 * 8), mb = *(const u32x4*)(OB + (size_t)row1 * 512 + h1 * 128 + l16 * 8), mg = *(const u32x4*)(GS + (size_t)row1 * 512 + h1 * 128 + l16 * 8);
    float a[8], b[8], g[8], c[8], d[8], f[8];
    unpack8(la, a); unpack8(lb, b); unpack8(lg, g); unpack8(ma, c); unpack8(mb, d); unpack8(mg, f);
    float ss = 0.f, st = 0.f;
#pragma unroll
    for (int e = 0; e < 8; ++e) { a[e] += b[e]; ss += a[e] * a[e]; c[e] += d[e]; st += c[e] * c[e]; }
    ss = sum16(ss); st = sum16(st);
    const float ri = rsqrtf(ss * (1.f / 128.f) + EPSF), rj = rsqrtf(st * (1.f / 128.f) + EPSF);
#pragma unroll
    for (int e = 0; e < 8; ++e) { a[e] = a[e] * ri * gn[e] * g[e]; c[e] = c[e] * rj * gn[e] * f[e]; }
    *(u32x4*)(CAT + (size_t)row * 1024 + h * 128 + l16 * 8) = pack8(a);
    if (has1) *(u32x4*)(CAT + (size_t)row1 * 1024 + h1 * 128 + l16 * 8) = pack8(c);
  }
}

__device__ __forceinline__ void phase9(const P& p) {
  const int tid = opaque_tid();
  const bf16_t* X = (const bf16_t*)p.out; const float* rsq = (const float*)(p.ws + OFF_RSQ); const float* mod = (const float*)(p.ws + OFF_MOD);
  bf16_t* MX = (bf16_t*)(p.ws + OFF_R1);
  float* rinv = (float*)g_shm;
  char* XS = g_shm + 256;
  const int c4 = tid & 255, half = tid >> 8;
  const int col = c4 * 4, win = 2 << (col >> 8), hw = win >> 1;
  for (int seg = BIDX(); seg < NTOK / 32; seg += GRIDX()) {
    const int row0 = seg * 32;
    int base, L; if (row0 < NCTX) { base = (row0 >> 8) << 8; L = 256; } else { base = NCTX + (((row0 - NCTX) >> 12) << 12); L = 4096; }
    const int p0 = row0 - base;
    __syncthreads();
#pragma unroll
    for (int i = 0; i < 12; ++i) {
      const int idx = tid + 512 * i, r = idx >> 7, cc = idx & 127, q = p0 - 8 + r;
      u32x4 v = (u32x4){0u, 0u, 0u, 0u};
      if (q >= 0 && q < L) v = *(const u32x4*)(X + (size_t)(base + q) * 1024 + cc * 8);
      *(u32x4*)(XS + r * 2048 + cc * 16) = v;
    }
    if (tid < 64) {
      int q = p0 - 16 + tid;
      if (q >= 0 && q < L) { int g = base + q; rinv[tid] = rsqrtf((rsq[g] + rsq[NTOK + g] + rsq[2 * NTOK + g] + rsq[3 * NTOK + g]) * (1.f / 1024.f) + EPSF); }
      else rinv[tid] = 0.f;
    }
    __syncthreads();
    const float* mc = mod + ((size_t)5 + row_cond(row0)) * 6144;
    f32x4 Gm;
    { f32x4 ng = *(const f32x4*)(p.norm_mix_g + 1024 + col), sc = *(const f32x4*)(mc + 1024 + col); Gm = ng * (sc + 1.f); }
    const int ps = p0 + half * 16;
    auto xn = [&](int q) -> f32x4 {
      const u32x2 xr = *(const u32x2*)(XS + (q - p0 + 8) * 2048 + col * 2);
      return (f32x4){bf_lo(xr[0]), bf_hi(xr[0]), bf_lo(xr[1]), bf_hi(xr[1])} * rinv[q - p0 + 16];
    };
    f32x4 sum = (f32x4){0.f, 0.f, 0.f, 0.f};
    for (int q = ps - hw; q < ps - hw + win; ++q) sum = sum + xn(q);
#pragma unroll 4
    for (int i = 0; i < 16; ++i) {
      const int t = ps + i;
      const int lo = max(t - hw, 0), hi = min(t - hw + win, L);
      const f32x4 xc = xn(t), xo = xn(t - hw), xi = xn(t - hw + win);
      f32x4 m = (sum * (1.f / (float)(hi - lo)) - xc) * Gm;
      u32x2 o; o[0] = pk_bf16(m[0], m[1]); o[1] = pk_bf16(m[2], m[3]);
      *(u32x2*)(MX + (size_t)(base + t) * 1024 + col) = o;
      sum = sum - xo + xi;
    }
  }
}

__device__ __forceinline__ void phase13(const P& p) {
  const int tid = opaque_tid(), lane = tid & 63, wid = tid >> 6;
  const float* rsq = (const float*)(p.ws + OFF_RSQ);
  const bf16_t* XF = (const bf16_t*)(p.ws + OFF_R1);
  const int rstep = GRIDX() * 8;
  for (int row = BIDX() * 8 + wid; row < NTOK; row += 2 * rstep) {
    const int row1 = row + rstep; const bool has1 = row1 < NTOK; const int r1 = has1 ? row1 : row;
    u32x2 xa[4], xb[4];
#pragma unroll
    for (int i = 0; i < 4; ++i) { const int k = i * 256 + lane * 4; xa[i] = *(const u32x2*)(XF + (size_t)row * 1024 + k); xb[i] = *(const u32x2*)(XF + (size_t)r1 * 1024 + k); }
    const float ria = rsqrtf((rsq[row] + rsq[NTOK + row] + rsq[2 * NTOK + row] + rsq[3 * NTOK + row]) * (1.f / 1024.f) + EPSF);
    const float rib = rsqrtf((rsq[r1] + rsq[NTOK + r1] + rsq[2 * NTOK + r1] + rsq[3 * NTOK + r1]) * (1.f / 1024.f) + EPSF);
#pragma unroll
    for (int i = 0; i < 4; ++i) {
      const int k = i * 256 + lane * 4;
      const f32x4 g = *(const f32x4*)(p.final_g + k);
      const f32x4 va = (f32x4){bf_lo(xa[i][0]), bf_hi(xa[i][0]), bf_lo(xa[i][1]), bf_hi(xa[i][1])};
      const f32x4 vb = (f32x4){bf_lo(xb[i][0]), bf_hi(xb[i][0]), bf_lo(xb[i][1]), bf_hi(xb[i][1])};
      *(f32x4*)(p.out + (size_t)row * 1024 + k) = va * ria * g;
      if (has1) *(f32x4*)(p.out + (size_t)row1 * 1024 + k) = vb * rib * g;
    }
  }
}

constexpr int NPHASE = 14;
template <int LO, int HI>
__global__ void __launch_bounds__(NTHREADS, 2) fwd_kernel(P p) {
  p.wv = __builtin_amdgcn_readfirstlane((int)(threadIdx.x >> 6));
  if constexpr (HI - LO > 1) { if (p.phase_lo == 0x7fffffff) cg::this_grid().sync();
    grid_bar_init(p); }
#define PH(k, call) if constexpr (LO <= (k) && (k) < HI) { if constexpr ((k) > LO) { grid_bar(p); } call; }
  PH(0, phase0(p))
  PH(1, phase1(p))
  PH(2, gemm_inproj(p))
  PH(3, phase3(p))
  PH(4, phase4(p))
  PH(5, phase5(p))
  PH(6, gemm_resid(p, 0, 0, (const bf16_t*)(p.ws + OFF_CAT), 1024, (const bf16_t*)(p.ws + OFF_WOUT), 1024, 16, (bf16_t*)(p.ws + OFF_R1)))
  PH(7, gemm_ffn_gu(p, 0, (const bf16_t*)(p.ws + OFF_R1)))
  PH(8, gemm_resid(p, 1, 0, (const bf16_t*)(p.ws + OFF_ACT), 2816, (const bf16_t*)(p.ws + OFF_WDN), 2816, 44, (bf16_t*)(p.ws + OFF_R1)))
  PH(9, phase9(p))
  PH(10, gemm_resid(p, 2, 1, (const bf16_t*)(p.ws + OFF_R1), 1024, (const bf16_t*)(p.ws + OFF_WPOOL), 256, 4, (bf16_t*)(p.ws + OFF_R1)))
  PH(11, gemm_ffn_gu(p, 1, (const bf16_t*)(p.ws + OFF_R1)))
  PH(12, gemm_resid(p, 1, 1, (const bf16_t*)(p.ws + OFF_ACT), 2816, (const bf16_t*)(p.ws + OFF_WDN) + (size_t)1024 * 2816, 2816, 44, (bf16_t*)(p.ws + OFF_R1)))
  PH(13, phase13(p))
#undef PH
}

__global__ void cks_kernel(const u32* ptr, size_t nwords, unsigned long long* slot) {
  unsigned long long s = 0;
  for (size_t i = (size_t)blockIdx.x * blockDim.x + threadIdx.x; i < nwords; i += (size_t)gridDim.x * blockDim.x) s += (unsigned long long)ptr[i] * (unsigned long long)((i & 1023) + 1);
  for (int o = 32; o > 0; o >>= 1) s += __shfl_xor(s, o, 64);
  if ((threadIdx.x & 63) == 0) atomicAdd(slot, s);
}
__global__ void cmp_kernel(const unsigned long long* slots, int nbuf, float* out, int n_y, int n_all) {
  int code = 0;
  for (int b = 0; b < nbuf; ++b) if (slots[b] != slots[64 + b]) { code = b + 1; break; }
  const float c = sqrtf(100.f * (float)code);
  for (int i = blockIdx.x * blockDim.x + threadIdx.x; i < n_all; i += gridDim.x * blockDim.x) out[i] = i < n_y ? c : 0.f;
}

__global__ void sanitize_kernel(float* o, int n) {
  for (int i = blockIdx.x * blockDim.x + threadIdx.x; i < n; i += gridDim.x * blockDim.x) { float v = o[i]; if (!(fabsf(v) < 3.0e38f)) o[i] = 0.f; }
}

extern "C" void kernel_launch(void* const* d_in, const int* in_sizes, int n_in, void* d_out, int out_size, void* d_ws, size_t ws_size, hipStream_t stream) {
  static int grid_blocks = 0;
#if COOP
  const void* kfn = (const void*)fwd_kernel<0, NPHASE>;
#else
  const void* kfns[NPHASE] = {(const void*)fwd_kernel<0, 1>, (const void*)fwd_kernel<1, 2>, (const void*)fwd_kernel<2, 3>, (const void*)fwd_kernel<3, 4>,
                              (const void*)fwd_kernel<4, 5>, (const void*)fwd_kernel<5, 6>, (const void*)fwd_kernel<6, 7>, (const void*)fwd_kernel<7, 8>,
                              (const void*)fwd_kernel<8, 9>, (const void*)fwd_kernel<9, 10>, (const void*)fwd_kernel<10, 11>, (const void*)fwd_kernel<11, 12>,
                              (const void*)fwd_kernel<12, 13>, (const void*)fwd_kernel<13, 14>};
#endif
  if (!grid_blocks) {
    int dev = 0, cus = 0;
    (void)hipGetDevice(&dev);
    (void)hipDeviceGetAttribute(&cus, hipDeviceAttributeMultiprocessorCount, dev);
#if COOP
    (void)hipFuncSetAttribute(kfn, hipFuncAttributeMaxDynamicSharedMemorySize, LDS_BYTES);
    int per_cu = 0;
    (void)hipOccupancyMaxActiveBlocksPerMultiprocessor(&per_cu, kfn, NTHREADS, LDS_BYTES);
    if (per_cu < 1) fprintf(stderr, "occupancy query returned %d\n", per_cu);
#else
    for (int i = 0; i < NPHASE; ++i) (void)hipFuncSetAttribute(kfns[i], hipFuncAttributeMaxDynamicSharedMemorySize, LDS_BYTES);
#endif
    grid_blocks = cus >= 8 ? (cus / 8) * 8 : 256;
  }
  P p{};
  p.x_prompt = (const float*)d_in[0]; p.x_sample = (const float*)d_in[1]; p.state = (const float*)d_in[2]; p.c = (const float*)d_in[3];
  p.c_ctx = (const float*)d_in[4]; p.norm_mix_g = (const float*)d_in[5]; p.norm_ffn_g = (const float*)d_in[6]; p.w_ada = (const float*)d_in[7];
  p.b_ada = (const float*)d_in[8]; p.w_in = (const float*)d_in[9]; p.conv_qkv = (const float*)d_in[10]; p.a_log = (const float*)d_in[11];
  p.dt_bias = (const float*)d_in[12]; p.o_norm_g = (const float*)d_in[13]; p.conv_b = (const float*)d_in[14]; p.w_out = (const float*)d_in[15];
  p.w_pool = (const float*)d_in[16]; p.pool_scale = (const float*)d_in[17]; p.w_gate = (const float*)d_in[18]; p.w_up = (const float*)d_in[19];
  p.ffn_conv = (const float*)d_in[20]; p.w_down = (const float*)d_in[21]; p.final_g = (const float*)d_in[22];
  p.out = (float*)d_out; p.ws = (char*)d_ws; p.nblk = grid_blocks; p.wv = 0;
#if COOP
  p.phase_lo = 0; p.phase_hi = NPHASE;
  void* args[] = {&p};
  (void)hipMemsetAsync((char*)d_ws + OFF_BAR, 0, XCD_BAR_WORDS * 4, stream);
  hipError_t e = hipLaunchCooperativeKernel(kfn, dim3(grid_blocks), dim3(NTHREADS), args, LDS_BYTES, stream);
  if (e != hipSuccess) fprintf(stderr, "cooperative launch failed: %s (grid %d)\n", hipGetErrorString(e), grid_blocks);
#else
  p.phase_lo = 0; p.phase_hi = 1;
  void* args[] = {&p};
#ifdef DBG
  {
    const size_t OFF_DBG = (size_t)255 * 1024 * 1024;
    unsigned long long* slots = (unsigned long long*)((char*)d_ws + OFF_DBG);
    (void)hipMemsetAsync(slots, 0, 4096, stream);
    struct CB { int after; const void* ptr; size_t bytes; };
    char* ws = (char*)d_ws; char* o = (char*)d_out;
    const CB cbs[] = {
      {1, ws + OFF_MOD, (size_t)2 * 5 * 6144 * 4}, {1, ws + OFF_WIN, OFF_SMALL}, {1, ws + OFF_SW, (size_t)2 * 5 * 5632 * 4}, {1, ws + OFF_PE, (size_t)64 * 512 * 4},
      {1, ws + OFF_G, (size_t)NTOK * 32}, {1, ws + OFF_BETA, (size_t)NTOK * 32}, {1, o, (size_t)NTOK * 4096}, {1, ws + OFF_R1, SZ_R1},
      {2, ws + OFF_Q, SZ_QKV}, {2, ws + OFF_K, SZ_QKV}, {2, ws + OFF_V, SZ_QKV}, {2, ws + OFF_GS, SZ_QKV},
      {3, ws + OFF_TP, (size_t)1536 * 8192}, {3, ws + OFF_AP, (size_t)1536 * 8192},
      {4, ws + OFF_OB, SZ_QKV}, {4, o + (size_t)NTOK * 4096, (size_t)32 * 2 * 4 * 16384 * 4},
      {5, ws + OFF_CAT, SZ_R1},
      {6, ws + OFF_R1, SZ_R1}, {6, o, (size_t)NTOK * 4096}, {6, ws + OFF_RSQ, (size_t)4 * NTOK * 4}};
    const int ncb = sizeof(cbs) / sizeof(cbs[0]);
    for (int run = 0; run < 2; ++run) {
      (void)hipMemsetAsync(d_ws, run ? 0xAA : 0x55, OFF_DBG, stream);
      (void)hipMemsetAsync(d_out, run ? 0xAA : 0x55, (size_t)out_size * 4, stream);
      for (int ph = 0; ph <= 6; ++ph) {
        (void)hipLaunchKernel(kfns[ph], dim3(grid_blocks), dim3(NTHREADS), args, LDS_BYTES, stream);
        for (int b = 0; b < ncb; ++b) if (cbs[b].after == ph)
          hipLaunchKernelGGL(cks_kernel, dim3(1024), dim3(256), 0, stream, (const u32*)cbs[b].ptr, cbs[b].bytes / 4, slots + run * 64 + b);
      }
    }
    hipLaunchKernelGGL(cmp_kernel, dim3(1024), dim3(256), 0, stream, (const unsigned long long*)slots, ncb, (float*)d_out, NTOK * 1024, out_size);
  }
#else
  for (int ph = 0; ph <= STOP_AFTER; ++ph) {
    hipError_t e = hipLaunchKernel(kfns[ph], dim3(grid_blocks), dim3(NTHREADS), args, LDS_BYTES, stream);
    if (e != hipSuccess) fprintf(stderr, "launch %d failed: %s\n", ph, hipGetErrorString(e));
  }
#ifdef SANITIZE
  hipLaunchKernelGGL(sanitize_kernel, dim3(1024), dim3(256), 0, stream, (float*)d_out, out_size);
#endif
#endif
#endif
}
```

```cpp
#include <hip/hip_runtime.h>
#include <hip/hip_cooperative_groups.h>
#include <cstdio>
namespace cg = cooperative_groups;

#ifndef COOP
#define COOP 1
#endif
#ifndef STOP_AFTER
#define STOP_AFTER 13
#endif


typedef unsigned short bf16_t;
typedef unsigned int u32;
typedef short bf16x8 __attribute__((ext_vector_type(8)));
typedef float f32x4 __attribute__((ext_vector_type(4)));
typedef u32 u32x4 __attribute__((ext_vector_type(4)));
typedef u32 u32x2 __attribute__((ext_vector_type(2)));

constexpr int NTOK = 24576, NCTX = 8192;
constexpr int NTHREADS = 512;
constexpr float EPSF = 1e-6f;
constexpr int LDS_TILE_BYTES = 256 * 544;
constexpr int LDS_BYTES = LDS_TILE_BYTES + 16;

constexpr size_t OFF_WIN = 0;
constexpr size_t OFF_WOUT = OFF_WIN + (size_t)3584 * 1024 * 2;
constexpr size_t OFF_WPOOL = OFF_WOUT + (size_t)1024 * 1024 * 2;
constexpr size_t OFF_WGU = OFF_WPOOL + (size_t)4 * 256 * 256 * 2;
constexpr size_t OFF_WDN = OFF_WGU + (size_t)2 * 5632 * 1024 * 2;
constexpr size_t OFF_SMALL = OFF_WDN + (size_t)2 * 1024 * 2816 * 2;
constexpr size_t OFF_MOD = OFF_SMALL;
constexpr size_t OFF_SW = OFF_MOD + (size_t)2 * 5 * 6144 * 4;
constexpr size_t OFF_PE = OFF_SW + (size_t)2 * 5 * 5632 * 4;
constexpr size_t OFF_G = OFF_PE + (size_t)64 * 512 * 4;
constexpr size_t OFF_BETA = OFF_G + (size_t)NTOK * 8 * 4;
constexpr size_t OFF_RSQ = OFF_BETA + (size_t)NTOK * 8 * 4;
constexpr size_t OFF_BAR = OFF_RSQ + (size_t)4 * NTOK * 4;
constexpr size_t OFF_R1 = OFF_SMALL + (size_t)4 * 1024 * 1024;
constexpr size_t SZ_R1 = (size_t)NTOK * 1024 * 2;
constexpr size_t OFF_BIG = OFF_R1 + SZ_R1;
constexpr size_t SZ_QKV = (size_t)NTOK * 512 * 2;
constexpr size_t OFF_Q = OFF_BIG, OFF_K = OFF_Q + SZ_QKV, OFF_V = OFF_K + SZ_QKV, OFF_GS = OFF_V + SZ_QKV, OFF_CAT = OFF_GS + SZ_QKV;
constexpr size_t OFF_ACT = OFF_BIG;
constexpr size_t OFF_TP = OFF_R1, OFF_AP = OFF_TP + (size_t)1536 * 4096 * 2, OFF_OB = OFF_AP + (size_t)1536 * 4096 * 2;

struct P {
  const float *x_prompt, *x_sample, *state, *c, *c_ctx, *norm_mix_g, *norm_ffn_g, *w_ada, *b_ada, *w_in, *conv_qkv, *a_log, *dt_bias,
      *o_norm_g, *conv_b, *w_out, *w_pool, *pool_scale, *w_gate, *w_up, *ffn_conv, *w_down, *final_g;
  float* out;
  char* ws;
  int phase_lo, phase_hi;
  int nblk, wv;
};

extern __shared__ __attribute__((aligned(1024))) char g_shm[];

typedef __bf16 bf16x2v __attribute__((ext_vector_type(2)));
typedef float f32x2v __attribute__((ext_vector_type(2)));
__device__ __forceinline__ u32 pk_bf16(float lo, float hi) { f32x2v f = {lo, hi}; bf16x2v b = __builtin_convertvector(f, bf16x2v); return __builtin_bit_cast(u32, b); }
__device__ __forceinline__ float bf_lo(u32 w) { return __uint_as_float(w << 16); }
__device__ __forceinline__ float bf_hi(u32 w) { return __uint_as_float(w & 0xffff0000u); }
__device__ __forceinline__ float bf2f(bf16_t v) { return __uint_as_float(((u32)v) << 16); }
__device__ __forceinline__ float silu_f(float x) { return x * __builtin_amdgcn_rcpf(1.f + __expf(-x)); }
__device__ __forceinline__ float sigm_f(float x) { return __builtin_amdgcn_rcpf(1.f + __expf(-x)); }
__device__ __forceinline__ void unpack8(u32x4 v, float (&o)[8]) {
  o[0] = bf_lo(v[0]); o[1] = bf_hi(v[0]); o[2] = bf_lo(v[1]); o[3] = bf_hi(v[1]);
  o[4] = bf_lo(v[2]); o[5] = bf_hi(v[2]); o[6] = bf_lo(v[3]); o[7] = bf_hi(v[3]);
}
__device__ __forceinline__ u32x4 pack8(const float (&o)[8]) {
  u32x4 v; v[0] = pk_bf16(o[0], o[1]); v[1] = pk_bf16(o[2], o[3]); v[2] = pk_bf16(o[4], o[5]); v[3] = pk_bf16(o[6], o[7]); return v;
}
template <int CTRL> __device__ __forceinline__ float dpp_mov(float v) {
  return __builtin_bit_cast(float, __builtin_amdgcn_update_dpp(0, __builtin_bit_cast(int, v), CTRL, 0xF, 0xF, true));
}
__device__ __forceinline__ float sum16(float v) {
  v += dpp_mov<0xB1>(v);
  v += dpp_mov<0x4E>(v);
  v += dpp_mov<0x141>(v);
  v += dpp_mov<0x140>(v);
  return v;
}
__device__ __forceinline__ float rdlane(float v, int l) { return __builtin_bit_cast(float, __builtin_amdgcn_readlane(__builtin_bit_cast(int, v), l)); }
__device__ __forceinline__ float wave_sum(float v) {
  v = sum16(v);
  return (rdlane(v, 0) + rdlane(v, 16)) + (rdlane(v, 32) + rdlane(v, 48));
}
template <int CTRL, int ROWMASK> __device__ __forceinline__ float dpp_add(float v) {
  return v + __builtin_bit_cast(float, __builtin_amdgcn_update_dpp(0, __builtin_bit_cast(int, v), CTRL, ROWMASK, 0xF, CTRL < 0x140));
}
__device__ __forceinline__ float wave_prefix(float g, int  ) {
  g = dpp_add<0x111, 0xF>(g);
  g = dpp_add<0x112, 0xF>(g);
  g = dpp_add<0x114, 0xF>(g);
  g = dpp_add<0x118, 0xF>(g);
  g = dpp_add<0x142, 0xA>(g);
  g = dpp_add<0x143, 0xC>(g);
  return g;
}
#define GRIDX() (p.nblk)
__device__ __forceinline__ int BIDX() { return (int)blockIdx.x; }
__device__ __forceinline__ int opaque_tid_w(int wv) { unsigned m = ~0u; asm volatile("" : "+s"(m)); int t = (wv << 6) | (int)__builtin_amdgcn_mbcnt_hi(m, __builtin_amdgcn_mbcnt_lo(m, 0u)); asm volatile("" : "+v"(t)); return t; }
#define opaque_tid() opaque_tid_w(p.wv)
__device__ __forceinline__ int row_cond(int row) { return row < NCTX ? 0 : 1 + ((row - NCTX) >> 12); }


#define XB_TMO      128
#define XB_XCNT(j)  (256  + 64 * (j))
#define XB_XSUB(j)  (1280 + 64 * (j))
#define XB_XGEN(j)  (2304 + 64 * (j))
#define XB_TOP      3328
#define XB_TOPGEN   3392
#define XCD_BAR_WORDS 3456
#define XB_SPIN_CAP (1u << 18)
#define LAS __attribute__((address_space(3)))
__device__ __forceinline__ unsigned xb_ld(unsigned* q)              { return __hip_atomic_load(q, __ATOMIC_RELAXED, __HIP_MEMORY_SCOPE_AGENT); }
__device__ __forceinline__ unsigned xb_add(unsigned* q, unsigned v) { return __hip_atomic_fetch_add(q, v, __ATOMIC_RELAXED, __HIP_MEMORY_SCOPE_AGENT); }
__device__ __forceinline__ unsigned xb_xcc_id() { return (unsigned)__builtin_amdgcn_s_getreg((3 << 11) | 20) & 0xFu; }
#define XB_SPIN(cond, bar) do { unsigned _sp = 0; while (cond) { __builtin_amdgcn_s_sleep(1); \
    if ((++_sp & 255u) == 0u) { if (xb_ld(&(bar)[XB_TMO])) break; if (_sp > XB_SPIN_CAP) { atomicAdd(&(bar)[XB_TMO], 1u); break; } } } } while (0)
__device__ __forceinline__ void xb_complete(unsigned* bar, unsigned x, unsigned G, unsigned& nloc, unsigned& nx) {
  unsigned sum, cnt, mine, sp = 0u;
  for (;;) {
    sum = 0u; cnt = 0u; mine = 0u;
#pragma unroll
    for (unsigned j = 0; j < 16; ++j) { const unsigned c = xb_ld(&bar[XB_XCNT(j)]); sum += c; cnt += (c > 0u) ? 1u : 0u; mine = (j == x) ? c : mine; }
    if (sum == G) break;
    __builtin_amdgcn_s_sleep(1);
    if ((++sp & 255u) == 0u) { if (xb_ld(&bar[XB_TMO])) break; if (sp > XB_SPIN_CAP) { atomicAdd(&bar[XB_TMO], 1u); break; } }
  }
  nloc = mine > 0u ? mine : 1u; nx = cnt > 0u ? cnt : 1u;
}
__device__ __forceinline__ void grid_bar_init(const P& p) {
  const int tid = opaque_tid();
  volatile LAS unsigned* st = (volatile LAS unsigned*)(g_shm + LDS_TILE_BYTES);
  if (tid == 0) { st[0] = 0u; st[1] = 0u; (void)xb_add(&((unsigned*)(p.ws + OFF_BAR))[XB_XCNT(xb_xcc_id())], 1u); }
  __syncthreads();
}
__device__ __forceinline__ void grid_bar(const P& p) {
  const int tid = opaque_tid();
  asm volatile("s_waitcnt vmcnt(0)" ::: "memory");
  __syncthreads();
  if (tid == 0) {
    unsigned* bar = (unsigned*)(p.ws + OFF_BAR);
    volatile LAS unsigned* st = (volatile LAS unsigned*)(g_shm + LDS_TILE_BYTES);
    const unsigned x = xb_xcc_id();
    __builtin_amdgcn_s_waitcnt(0);
    unsigned nloc = st[0], nx = st[1];
    if (nloc == 0u) { xb_complete(bar, x, (unsigned)p.nblk, nloc, nx); st[0] = nloc; st[1] = nx; }
    const unsigned old = xb_add(&bar[XB_XSUB(x)], 1u);
    const unsigned gen = old / nloc;
    if (old + 1u == (gen + 1u) * nloc) {
      __builtin_amdgcn_fence(__ATOMIC_RELEASE, "agent");
      asm volatile("s_waitcnt vmcnt(0)" ::: "memory");
      const unsigned og = xb_add(&bar[XB_TOP], 1u);
      const unsigned tg = og / nx;
      if (og + 1u == (tg + 1u) * nx) xb_add(&bar[XB_TOPGEN], 1u);
      else XB_SPIN(xb_ld(&bar[XB_TOPGEN]) == tg, bar);
      __builtin_amdgcn_fence(__ATOMIC_ACQUIRE, "agent");
      xb_add(&bar[XB_XGEN(x)], 1u);
      asm volatile("s_waitcnt vmcnt(0)" ::: "memory");
    } else {
      XB_SPIN(xb_ld(&bar[XB_XGEN(x)]) == gen, bar);
      __builtin_amdgcn_fence(__ATOMIC_ACQUIRE, "agent");
      asm volatile("s_waitcnt vmcnt(0)" ::: "memory");
    }
  }
  __syncthreads();
}

struct CvtTile { const float* src; bf16_t* dst; int ld_src, ld_dst; };
__device__ __forceinline__ CvtTile cvt_desc(const P& p, int t) {
  bf16_t* Win = (bf16_t*)(p.ws + OFF_WIN); bf16_t* Wout = (bf16_t*)(p.ws + OFF_WOUT); bf16_t* Wpool = (bf16_t*)(p.ws + OFF_WPOOL);
  bf16_t* Wgu = (bf16_t*)(p.ws + OFF_WGU); bf16_t* Wdn = (bf16_t*)(p.ws + OFF_WDN);
  CvtTile d;
  if (t < 896) {
    int j = t >> 4, kc = t & 15, sc;
    if (j < 24) sc = j * 64; else { int jj = j - 24, m = jj >> 2, part = jj & 3; sc = (part == 0 ? 2064 : part == 1 ? 2576 : part == 2 ? 3088 : 1536) + m * 64; }
    d.src = p.w_in + (size_t)kc * 64 * 3600 + sc; d.ld_src = 3600; d.dst = Win + (size_t)j * 64 * 1024 + kc * 64; d.ld_dst = 1024;
  } else if (t < 1152) {
    int u = t - 896, j = u >> 4, kc = u & 15;
    d.src = p.w_out + (size_t)kc * 64 * 1024 + j * 64; d.ld_src = 1024; d.dst = Wout + (size_t)j * 64 * 1024 + kc * 64; d.ld_dst = 1024;
  } else if (t < 1216) {
    int u = t - 1152, g = u >> 4, j = (u >> 2) & 3, kc = u & 3;
    d.src = p.w_pool + (size_t)g * 65536 + (size_t)kc * 64 * 256 + j * 64; d.ld_src = 256; d.dst = Wpool + (size_t)g * 65536 + (size_t)j * 64 * 256 + kc * 64; d.ld_dst = 256;
  } else if (t < 4032) {
    int u = t - 1216, l = u / 1408, v = u % 1408, j = v >> 4, kc = v & 15, nt = j >> 2, part = j & 3;
    d.src = (part < 2 ? p.w_gate : p.w_up) + (size_t)l * 1024 * 2816 + (size_t)kc * 64 * 2816 + nt * 128 + (part & 1) * 64; d.ld_src = 2816;
    d.dst = Wgu + (size_t)l * 5632 * 1024 + (size_t)j * 64 * 1024 + kc * 64; d.ld_dst = 1024;
  } else {
    int u = t - 4032, l = u / 704, v = u % 704, j = v / 44, kc = v % 44;
    d.src = p.w_down + (size_t)l * 2816 * 1024 + (size_t)kc * 64 * 1024 + j * 64; d.ld_src = 1024;
    d.dst = Wdn + (size_t)l * 1024 * 2816 + (size_t)j * 64 * 2816 + kc * 64; d.ld_dst = 2816;
  }
  return d;
}
__device__ __forceinline__ void cvt_loop(const P& p, int t, const int tend, const int tstride, const int tid) {
  float* tile = (float*)g_shm;
  const int kk0 = tid >> 4, c4 = tid & 15, wn = tid >> 3, wkc = tid & 7;
  float4 v0, v1;
  if (t < tend) { CvtTile d = cvt_desc(p, t); v0 = *(const float4*)(d.src + (size_t)kk0 * d.ld_src + c4 * 4); v1 = *(const float4*)(d.src + (size_t)(kk0 + 32) * d.ld_src + c4 * 4); }
  while (t < tend) {
    const CvtTile d = cvt_desc(p, t);
    { float* q = tile + kk0 * 65 + c4 * 4; q[0] = v0.x; q[1] = v0.y; q[2] = v0.z; q[3] = v0.w;
      q = tile + (kk0 + 32) * 65 + c4 * 4; q[0] = v1.x; q[1] = v1.y; q[2] = v1.z; q[3] = v1.w; }
    const int tn = t + tstride;
    if (tn < tend) { CvtTile e = cvt_desc(p, tn); v0 = *(const float4*)(e.src + (size_t)kk0 * e.ld_src + c4 * 4); v1 = *(const float4*)(e.src + (size_t)(kk0 + 32) * e.ld_src + c4 * 4); }
    __syncthreads();
    { float o[8];
#pragma unroll
      for (int e = 0; e < 8; ++e) o[e] = tile[(wkc * 8 + e) * 65 + wn];
      *(u32x4*)(d.dst + (size_t)wn * d.ld_dst + wkc * 8) = pack8(o); }
    __syncthreads();
    t = tn;
  }
}

__device__ __forceinline__ void phase0(const P& p) {
  const int tid = opaque_tid();
  float* sl = (float*)g_shm;
  float* red = (float*)(g_shm + 20480);
#pragma unroll
  for (int i = tid; i < 5120; i += NTHREADS) { int c = i >> 10, k = i & 1023; float v = c == 0 ? p.c_ctx[k] : p.c[(c - 1) * 1024 + k]; sl[i] = silu_f(v); }
  __syncthreads();
  float* mod = (float*)(p.ws + OFF_MOD);
  for (int item = BIDX(); item < 256; item += GRIDX()) {
    const int gcol0 = item * 48, layer = gcol0 / 6144, n0 = gcol0 % 6144;
    if (tid < 504) {
      const int cgp = tid % 12, kg = tid / 12;
      float acc[5][4];
#pragma unroll
      for (int c = 0; c < 5; ++c)
#pragma unroll
        for (int e = 0; e < 4; ++e) acc[c][e] = 0.f;
      for (int k0 = kg; k0 < 1024; k0 += 42 * 8) {
        float4 w[8];
#pragma unroll
        for (int u = 0; u < 8; ++u) { const int k = k0 + 42 * u; w[u] = k < 1024 ? *(const float4*)(p.w_ada + ((size_t)layer * 1024 + k) * 6144 + n0 + cgp * 4) : make_float4(0.f, 0.f, 0.f, 0.f); }
#pragma unroll
        for (int u = 0; u < 8; ++u) {
          const int k = k0 + 42 * u;
          if (k < 1024) {
#pragma unroll
            for (int c = 0; c < 5; ++c) { float s = sl[c * 1024 + k]; acc[c][0] += s * w[u].x; acc[c][1] += s * w[u].y; acc[c][2] += s * w[u].z; acc[c][3] += s * w[u].w; }
          }
        }
      }
#pragma unroll
      for (int c = 0; c < 5; ++c)
#pragma unroll
        for (int e = 0; e < 4; ++e) red[(kg * 5 + c) * 48 + cgp * 4 + e] = acc[c][e];
    }
    __syncthreads();
    if (tid < 240) {
      int c = tid / 48, n = tid % 48; float s = 0.f;
      for (int kg = 0; kg < 42; ++kg) s += red[(kg * 5 + c) * 48 + n];
      mod[((size_t)layer * 5 + c) * 6144 + n0 + n] = s + p.b_ada[layer * 6144 + n0 + n];
    }
    __syncthreads();
  }
  cvt_loop(p, BIDX(), 1216, GRIDX(), tid);
  float* pe = (float*)(p.ws + OFF_PE);
  for (int idx = BIDX() * NTHREADS + tid; idx < 32768; idx += GRIDX() * NTHREADS) {
    int pp = idx >> 9, e = idx & 511, ee = e & 255;
    float omega = 1.0f / powf(10000.0f, (float)ee / 256.0f);
    float a = (float)pp * omega;
    pe[idx] = e < 256 ? sinf(a) : cosf(a);
  }
}

__device__ __forceinline__ void phase1(const P& p) {
  const int tid = opaque_tid(), lane = tid & 63, wid = tid >> 6;
  float* wl = (float*)g_shm;
  const float* mod = (const float*)(p.ws + OFF_MOD);
#pragma unroll 16
  for (int idx = tid; idx < 16384; idx += NTHREADS) { int k = idx >> 4, j = idx & 15; wl[j * 1024 + k] = p.w_in[(size_t)k * 3600 + 2048 + j]; }
  __syncthreads();
  const float* pe = (const float*)(p.ws + OFF_PE);
  bf16_t* h0 = (bf16_t*)(p.ws + OFF_R1);
  float* gb = (float*)(p.ws + OFF_G); float* bb = (float*)(p.ws + OFF_BETA);
  f32x4 Gv[4];
#pragma unroll
  for (int i = 0; i < 4; ++i) Gv[i] = *(const f32x4*)(p.norm_mix_g + i * 256 + lane * 4);
  for (int it = BIDX(); it < NTOK / 16; it += GRIDX()) {
    float h[2][16];
    const int rowA = it * 16 + wid * 2;
    const bool lat = rowA >= NCTX;
    const float* src = lat ? p.x_sample + (size_t)(rowA - NCTX) * 1024 : p.x_prompt + (size_t)rowA * 1024;
    const float* mc = mod + (size_t)row_cond(rowA) * 6144;
    f32x4 xv[2][4], scv[4], shv[4];
#pragma unroll
    for (int rr = 0; rr < 2; ++rr)
#pragma unroll
      for (int i = 0; i < 4; ++i) xv[rr][i] = *(const f32x4*)(src + rr * 1024 + i * 256 + lane * 4);
    if (lat) {
#pragma unroll
      for (int rr = 0; rr < 2; ++rr) {
        const int pos = (rowA + rr - NCTX) & 4095, pr = pos >> 6, pc = pos & 63;
#pragma unroll
        for (int i = 0; i < 4; ++i) { const int k = i * 256 + lane * 4; xv[rr][i] = xv[rr][i] + *(const f32x4*)(pe + (k < 512 ? pr * 512 + k : pc * 512 + k - 512)); }
      }
    }
#pragma unroll
    for (int i = 0; i < 4; ++i) { const int k = i * 256 + lane * 4; scv[i] = *(const f32x4*)(mc + 1024 + k); shv[i] = *(const f32x4*)(mc + k); }
#pragma unroll
    for (int rr = 0; rr < 2; ++rr) {
      const int row = rowA + rr;
      float ss = 0.f;
#pragma unroll
      for (int i = 0; i < 4; ++i) {
        const int k = i * 256 + lane * 4; const f32x4 v = xv[rr][i];
        { u32x2 xo; xo[0] = pk_bf16(v[0], v[1]); xo[1] = pk_bf16(v[2], v[3]); *(u32x2*)((bf16_t*)p.out + (size_t)row * 1024 + k) = xo; }
        ss += v[0] * v[0] + v[1] * v[1] + v[2] * v[2] + v[3] * v[3];
      }
      ss = wave_sum(ss);
      const float rinv = rsqrtf(ss * (1.f / 1024.f) + EPSF);
#pragma unroll
      for (int i = 0; i < 4; ++i) {
        const int k = i * 256 + lane * 4;
        const f32x4 hv = xv[rr][i] * rinv * Gv[i] * (scv[i] + 1.f) + shv[i];
        h[rr][i * 4 + 0] = hv[0]; h[rr][i * 4 + 1] = hv[1]; h[rr][i * 4 + 2] = hv[2]; h[rr][i * 4 + 3] = hv[3];
        u32x2 o; o[0] = pk_bf16(hv[0], hv[1]); o[1] = pk_bf16(hv[2], hv[3]);
        *(u32x2*)(h0 + (size_t)row * 1024 + k) = o;
      }
    }
    f32x2v hp[16];
#pragma unroll
    for (int k = 0; k < 16; ++k) hp[k] = (f32x2v){h[0][k], h[1][k]};
    float my0 = 0.f, my1 = 0.f;
#pragma unroll 2
    for (int j = 0; j < 16; ++j) {
      f32x2v ap = {0.f, 0.f};
#pragma unroll
      for (int i = 0; i < 4; ++i) {
        float4 w = *(const float4*)(wl + j * 1024 + i * 256 + lane * 4);
        ap += w.x * hp[i * 4] + w.y * hp[i * 4 + 1];
        ap += w.z * hp[i * 4 + 2] + w.w * hp[i * 4 + 3];
      }
      float a0 = wave_sum(ap[0]), a1 = wave_sum(ap[1]);
      if (lane == j) { my0 = a0; my1 = a1; }
    }
    if (lane < 16) {
#pragma unroll
      for (int rr = 0; rr < 2; ++rr) {
        const int row = it * 16 + wid * 2 + rr; float v = rr ? my1 : my0;
        if (lane < 8) bb[(size_t)row * 8 + lane] = sigm_f(v);
        else {
          int q = lane - 8; float z = v + p.dt_bias[q];
          float sp = z > 20.f ? z : log1pf(__expf(z));
          gb[(size_t)row * 8 + q] = -__expf(p.a_log[q]) * sp;
        }
      }
    }
  }

}

__device__ __forceinline__ int lds_byte(int r, int c) {
  int st = (r >> 4) * 2 + (c >> 5), ob = (r & 15) * 64 + (c & 31) * 2;
  return st * 1024 + (ob ^ (((ob >> 9) & 1) << 5));
}
__device__ __forceinline__ void stage_rc(int b, int& R, int& C) {
  int st = b >> 10, sb = b & 1023, swz = sb ^ (((sb >> 9) & 1) << 5);
  R = (st >> 1) * 16 + swz / 64;
  C = (st & 1) * 32 + (swz % 64) / 2;
}
constexpr int TILE_B = 256 * 64 * 2, STAGE_B = 2 * TILE_B;
#define WAIT_V0() asm volatile("s_waitcnt vmcnt(0)" ::: "memory")

template <int MT>
__device__ __forceinline__ void gemm_tile(f32x4 (&acc)[MT][4], const bf16_t* A, const u32 (&aoff)[4], const bf16_t* B, const u32 (&boff)[4], int nt, int tid) {
  const int wid = tid >> 6, lane = tid & 63, wr = wid >> 2, wc = wid & 3, fr = lane & 15, fq = lane >> 4;
#pragma unroll
  for (int m = 0; m < MT; ++m)
#pragma unroll
    for (int n = 0; n < 4; ++n) acc[m][n] = (f32x4){0.f, 0.f, 0.f, 0.f};
#define GSTAGE(buf, kt) do { _Pragma("unroll") for (int i = 0; i < 4; ++i) { \
    if (i < MT / 2) __builtin_amdgcn_global_load_lds((const u32*)(A + aoff[i] + (kt) * 64), (__attribute__((address_space(3))) u32*)(g_shm + (buf) * STAGE_B + wid * 1024 + i * 8192), 16, 0, 0); \
    __builtin_amdgcn_global_load_lds((const u32*)(B + boff[i] + (kt) * 64), (__attribute__((address_space(3))) u32*)(g_shm + (buf) * STAGE_B + TILE_B + wid * 1024 + i * 8192), 16, 0, 0); } } while (0)
  GSTAGE(0, 0); WAIT_V0(); __syncthreads();
  for (int t = 0; t < nt; ++t) {
    const int cur = t & 1;
    if (t + 1 < nt) GSTAGE(cur ^ 1, t + 1);
    const char* sa = g_shm + cur * STAGE_B; const char* sb = sa + TILE_B;
#pragma unroll
    for (int ks = 0; ks < 2; ++ks) {
      bf16x8 At[MT], Bf[4];
#pragma unroll
      for (int m = 0; m < MT; ++m) At[m] = *(const bf16x8*)(sa + lds_byte(wr * (MT * 16) + m * 16 + fr, ks * 32 + fq * 8));
#pragma unroll
      for (int n = 0; n < 4; ++n) Bf[n] = *(const bf16x8*)(sb + lds_byte(wc * 64 + n * 16 + fr, ks * 32 + fq * 8));
#pragma unroll
      for (int m = 0; m < MT; ++m)
#pragma unroll
        for (int n = 0; n < 4; ++n) acc[m][n] = __builtin_amdgcn_mfma_f32_16x16x32_bf16(Bf[n], At[m], acc[m][n], 0, 0, 0);
      __builtin_amdgcn_sched_barrier(0);
    }
    WAIT_V0(); __syncthreads();
  }
#undef GSTAGE
}


__device__ __forceinline__ void gemm_tile8p(f32x4 (&acc)[2][2][4][2], const bf16_t* A, size_t ahstep, const u32 (&voffA)[2], const bf16_t* B, size_t bhstep, const u32 (&voffB)[2], int nt, int tid) {
  const int wid = tid >> 6, lane = tid & 63, wr = wid >> 2, wc = wid & 3, fr = lane & 15, fq = lane >> 4;
#pragma unroll
  for (int ai = 0; ai < 2; ++ai)
#pragma unroll
    for (int bj = 0; bj < 2; ++bj)
#pragma unroll
      for (int m = 0; m < 4; ++m)
#pragma unroll
        for (int n = 0; n < 2; ++n) acc[ai][bj][m][n] = (f32x4){0.f, 0.f, 0.f, 0.f};
#define P8_SA(b, h) (g_shm + ((b) * 2 + (h)) * 16384)
#define P8_SB(b, h) (g_shm + (4 + (b) * 2 + (h)) * 16384)
#define P8_STA(b, h, kt) do { _Pragma("unroll") for (int _i = 0; _i < 2; ++_i) \
    __builtin_amdgcn_global_load_lds((const u32*)((const char*)(A + (h) * ahstep + (kt) * 64) + voffA[_i]), (__attribute__((address_space(3))) u32*)(P8_SA(b, h) + wid * 1024 + _i * 8192), 16, 0, 0); } while (0)
#define P8_STB(b, h, kt) do { _Pragma("unroll") for (int _i = 0; _i < 2; ++_i) \
    __builtin_amdgcn_global_load_lds((const u32*)((const char*)(B + (h) * bhstep + (kt) * 64) + voffB[_i]), (__attribute__((address_space(3))) u32*)(P8_SB(b, h) + wid * 1024 + _i * 8192), 16, 0, 0); } while (0)
#define P8_LDA(dst, b, h) do { _Pragma("unroll") for (int m = 0; m < 4; ++m) _Pragma("unroll") for (int k = 0; k < 2; ++k) \
    dst[m][k] = *(const bf16x8*)(P8_SA(b, h) + lds_byte(wr * 64 + m * 16 + fr, k * 32 + fq * 8)); } while (0)
#define P8_LDB(dst, b, h) do { _Pragma("unroll") for (int n = 0; n < 2; ++n) _Pragma("unroll") for (int k = 0; k < 2; ++k) \
    dst[n][k] = *(const bf16x8*)(P8_SB(b, h) + lds_byte(wc * 32 + n * 16 + fr, k * 32 + fq * 8)); } while (0)
#define P8_MMA(ai, bj, Af, Bfr) do { __builtin_amdgcn_s_setprio(1); \
    _Pragma("unroll") for (int m = 0; m < 4; ++m) _Pragma("unroll") for (int n = 0; n < 2; ++n) _Pragma("unroll") for (int k = 0; k < 2; ++k) \
      acc[ai][bj][m][n] = __builtin_amdgcn_mfma_f32_16x16x32_bf16(Bfr[n][k], Af[m][k], acc[ai][bj][m][n], 0, 0, 0); \
    __builtin_amdgcn_s_setprio(0); } while (0)
#define P8_WV(n) asm volatile("s_waitcnt vmcnt(" #n ")" ::: "memory")
#define P8_WL(n) asm volatile("s_waitcnt lgkmcnt(" #n ")" ::: "memory")
#define P8_BAR __builtin_amdgcn_s_barrier()
#define P8_SCHED __builtin_amdgcn_sched_barrier(0)
  bf16x8 At[4][2], B0[2][2], B1[2][2];
  __builtin_amdgcn_s_waitcnt(0x0F70);
  P8_STB(0, 0, 0); P8_STA(0, 0, 0); P8_STB(0, 1, 0); P8_STA(0, 1, 0);
  if (wr == 1) P8_BAR;
  P8_WV(4); P8_BAR;
  P8_STB(1, 0, 1); P8_STA(1, 0, 1); P8_STB(1, 1, 1);
  P8_WV(6); P8_BAR;
  for (int t = 0; t < nt - 2; t += 2) {
    P8_LDB(B0, 0, 0); P8_SCHED; P8_LDA(At, 0, 0); P8_STA(1, 1, t + 1);
    P8_WL(8); P8_BAR; P8_WL(0); P8_MMA(0, 0, At, B0); P8_BAR; P8_SCHED;
    P8_LDB(B1, 0, 1); P8_STB(0, 0, t + 2);
    P8_BAR; P8_WL(0); P8_MMA(0, 1, At, B1); P8_BAR;
    P8_LDA(At, 0, 1); P8_STA(0, 0, t + 2);
    P8_BAR; P8_WL(0); P8_MMA(1, 0, At, B0); P8_BAR; P8_SCHED;
    P8_STB(0, 1, t + 2);
    P8_WV(6); P8_BAR; P8_MMA(1, 1, At, B1); P8_BAR;
    P8_LDB(B0, 1, 0); P8_SCHED; P8_LDA(At, 1, 0); P8_STA(0, 1, t + 2);
    P8_WL(8); P8_BAR; P8_WL(0); P8_MMA(0, 0, At, B0); P8_BAR; P8_SCHED;
    P8_LDB(B1, 1, 1); P8_STB(1, 0, t + 3);
    P8_BAR; P8_WL(0); P8_MMA(0, 1, At, B1); P8_BAR;
    P8_LDA(At, 1, 1); P8_STA(1, 0, t + 3);
    P8_BAR; P8_WL(0); P8_MMA(1, 0, At, B0); P8_BAR; P8_SCHED;
    P8_STB(1, 1, t + 3);
    P8_WV(6); P8_BAR; P8_MMA(1, 1, At, B1); P8_BAR;
  }
  { P8_LDB(B0, 0, 0); P8_LDA(At, 0, 0); P8_STA(1, 1, nt - 1);
    P8_BAR; P8_WL(0); P8_MMA(0, 0, At, B0); P8_BAR;
    P8_LDB(B1, 0, 1); P8_BAR; P8_WL(0); P8_MMA(0, 1, At, B1); P8_BAR;
    P8_LDA(At, 0, 1); P8_WV(4); P8_BAR; P8_WL(0); P8_MMA(1, 0, At, B0); P8_MMA(1, 1, At, B1); P8_BAR; }
  { P8_LDB(B0, 1, 0); P8_LDA(At, 1, 0); P8_WV(2); P8_BAR; P8_WL(0); P8_MMA(0, 0, At, B0); P8_BAR;
    P8_LDB(B1, 1, 1); P8_WV(0); P8_BAR; P8_WL(0); P8_MMA(0, 1, At, B1); P8_BAR;
    P8_LDA(At, 1, 1); P8_BAR; P8_WL(0); P8_MMA(1, 0, At, B0); P8_MMA(1, 1, At, B1); P8_BAR; }
  if (wr == 0) P8_BAR;
  __syncthreads();
}

__device__ __forceinline__ void tile_map(int v, int nM, int nN, int& pm, int& pn) {
  int nig = 8 * nN, gid = v / nig, fm = gid * 8, gsz = min(nM - fm, 8);
  pm = fm + (v % nig) % gsz; pn = (v % nig) / gsz;
}
__device__ __forceinline__ int block_lin(const P& p) {
  const int b = BIDX(), G = GRIDX();
  return (b & 7) * (G >> 3) + (b >> 3);
}

struct MTile { int base, L, ts, lo, hi; };
__device__ __forceinline__ MTile mtile_conv(int mt) {
  MTile t;
  if (mt < 32) { t.base = mt * 256; t.L = 256; t.ts = 0; t.lo = 0; t.hi = 256; }
  else { int lt = mt - 32, s = lt / 17, j = lt % 17; t.base = NCTX + s * 4096; t.L = 4096; t.ts = 254 * j - 1; t.lo = 1; t.hi = min(255, 4096 - t.ts); }
  return t;
}
__device__ __forceinline__ int mt_grow(const MTile& t, int lr) { return t.base + min(max(t.ts + lr, 0), t.L - 1); }
__device__ __forceinline__ bool mt_valid(const MTile& t, int lr) { int q = t.ts + lr; return lr >= 0 && lr < 256 && q >= 0 && q < t.L; }

__device__ __forceinline__ void ct_load8(int lr, int colbyte, float (&o)[8]) { unpack8(*(const u32x4*)(g_shm + lr * 544 + colbyte), o); }
__device__ __forceinline__ void ct_load8z(const MTile& t, int lr, int colbyte, float (&o)[8]) {
  if (mt_valid(t, lr)) ct_load8(lr, colbyte, o);
  else {
#pragma unroll
    for (int e = 0; e < 8; ++e) o[e] = 0.f;
  }
}

__device__ __forceinline__ void gemm_inproj(const P& p) {
  const bf16_t* A = (const bf16_t*)(p.ws + OFF_R1); const bf16_t* B = (const bf16_t*)(p.ws + OFF_WIN);
  bf16_t* Q = (bf16_t*)(p.ws + OFF_Q); bf16_t* K = (bf16_t*)(p.ws + OFF_K); bf16_t* V = (bf16_t*)(p.ws + OFF_V);
  bf16_t* GS = (bf16_t*)(p.ws + OFF_GS); bf16_t* CAT = (bf16_t*)(p.ws + OFF_CAT);
  const int nM = 100, nN = 14, G = GRIDX(), lin = block_lin(p);
  for (int v = lin; v < nM * nN; v += G) {
    const int tid = opaque_tid();
    int sR[4], sC[4];
    { const int wid = tid >> 6, lane = tid & 63;
#pragma unroll
      for (int i = 0; i < 4; ++i) stage_rc(wid * 1024 + i * 8192 + lane * 16, sR[i], sC[i]); }
    int pm, pn; tile_map(v, nM, nN, pm, pn);
    const MTile mt = mtile_conv(pm);
    u32 voffA[2], voffB[2];
#pragma unroll
    for (int i = 0; i < 2; ++i) { voffA[i] = (u32)(sR[i] * 1024 + sC[i]) * 2u; voffB[i] = voffA[i]; }
    f32x4 acc[2][2][4][2];
    gemm_tile8p(acc, A + (long)(mt.base + mt.ts) * 1024, (size_t)128 * 1024, voffA, B + (size_t)pn * 256 * 1024, (size_t)128 * 1024, voffB, 16, tid);
    asm volatile("" ::: "memory");
    const int tide = opaque_tid();
    const int wid = tide >> 6, lane = tide & 63, wr = wid >> 2, wc = wid & 3, fr = lane & 15, fq = lane >> 4; (void)wid; (void)lane;
#pragma unroll
    for (int ai = 0; ai < 2; ++ai)
#pragma unroll
      for (int bj = 0; bj < 2; ++bj)
#pragma unroll
        for (int m = 0; m < 4; ++m)
#pragma unroll
          for (int n = 0; n < 2; ++n) {
            const f32x4 a = acc[ai][bj][m][n];
            u32x2 o; o[0] = pk_bf16(a[0], a[1]); o[1] = pk_bf16(a[2], a[3]);
            *(u32x2*)(g_shm + (ai * 128 + wr * 64 + m * 16 + fr) * 544 + (bj * 128 + wc * 32 + n * 16 + fq * 4) * 2) = o;
          }
    __syncthreads();
    if (pn < 6) {
      const int cc = tide & 31, rg = tide >> 5, lr0 = rg * 16;
      float w0[8], w1[8], w2[8];
#pragma unroll
      for (int e = 0; e < 8; ++e) { int col = pn * 256 + cc * 8 + e; w0[e] = p.conv_qkv[col]; w1[e] = p.conv_qkv[1536 + col]; w2[e] = p.conv_qkv[3072 + col]; }
      bf16_t* dst = pn < 2 ? Q : pn < 4 ? K : V;
      const int dcol = (pn & 1) * 256 + cc * 8;
      const float post = pn < 2 ? 0.08838834764831845f : 1.f;
      float prev[8], cur[8], nxt[8];
      ct_load8z(mt, lr0 - 1, cc * 16, prev); ct_load8z(mt, lr0, cc * 16, cur);
#pragma unroll 4
      for (int i = 0; i < 16; ++i) {
        const int lr = lr0 + i;
        ct_load8z(mt, lr + 1, cc * 16, nxt);
        float o[8]; float ss = 0.f;
#pragma unroll
        for (int e = 0; e < 8; ++e) { float u = w0[e] * prev[e] + w1[e] * cur[e] + w2[e] * nxt[e]; o[e] = silu_f(u); ss += o[e] * o[e]; }
        if (pn < 4) {
          ss = sum16(ss);
          const float sc = rsqrtf(ss + EPSF) * post;
#pragma unroll
          for (int e = 0; e < 8; ++e) o[e] *= sc;
        }
        if (lr >= mt.lo && lr < mt.hi) *(u32x4*)(dst + (size_t)mt_grow(mt, lr) * 512 + dcol) = pack8(o);
#pragma unroll
        for (int e = 0; e < 8; ++e) { prev[e] = cur[e]; cur[e] = nxt[e]; }
      }
    } else {
      const int mm = pn - 6, cc = tide & 7, rg = tide >> 3, lr0 = rg * 4;
      float w0[8], w1[8], w2[8];
#pragma unroll
      for (int e = 0; e < 8; ++e) { int col = mm * 64 + cc * 8 + e; w0[e] = p.conv_b[col]; w1[e] = p.conv_b[512 + col]; w2[e] = p.conv_b[1024 + col]; }
      float prev[8], cur[8], nxt[8], t1[8], t2[8];
      ct_load8z(mt, lr0 - 1, 128 + cc * 16, t1); ct_load8z(mt, lr0 - 1, 256 + cc * 16, t2);
#pragma unroll
      for (int e = 0; e < 8; ++e) prev[e] = t1[e] * t2[e];
      ct_load8z(mt, lr0, 128 + cc * 16, t1); ct_load8z(mt, lr0, 256 + cc * 16, t2);
#pragma unroll
      for (int e = 0; e < 8; ++e) cur[e] = t1[e] * t2[e];
#pragma unroll
      for (int i = 0; i < 4; ++i) {
        const int lr = lr0 + i;
        ct_load8z(mt, lr + 1, 128 + cc * 16, t1); ct_load8z(mt, lr + 1, 256 + cc * 16, t2);
#pragma unroll
        for (int e = 0; e < 8; ++e) nxt[e] = t1[e] * t2[e];
        if (lr >= mt.lo && lr < mt.hi) {
          float bg[8], gt[8], o[8], o2[8];
          ct_load8(lr, cc * 16, bg); ct_load8(lr, 384 + cc * 16, gt);
#pragma unroll
          for (int e = 0; e < 8; ++e) { o[e] = bg[e] * (w0[e] * prev[e] + w1[e] * cur[e] + w2[e] * nxt[e]); o2[e] = silu_f(gt[e]); }
          const size_t grow = (size_t)mt_grow(mt, lr);
          *(u32x4*)(CAT + grow * 1024 + 512 + mm * 64 + cc * 8) = pack8(o);
          *(u32x4*)(GS + grow * 512 + mm * 64 + cc * 8) = pack8(o2);
        }
#pragma unroll
        for (int e = 0; e < 8; ++e) { prev[e] = cur[e]; cur[e] = nxt[e]; }
      }
    }
    __syncthreads();
  }
}

__device__ __forceinline__ void gemm_ffn_gu(const P& p, int layer, const bf16_t* A) {
  const bf16_t* B = (const bf16_t*)(p.ws + OFF_WGU) + (size_t)layer * 5632 * 1024;
  bf16_t* ACT = (bf16_t*)(p.ws + OFF_ACT);
  const float* rsq = (const float*)(p.ws + OFF_RSQ);
  const float* sW = (const float*)(p.ws + OFF_SW);
  const float* cw = p.ffn_conv + (size_t)layer * 3 * 2816;
  const int nM = 100, nN = 22, G = GRIDX(), lin = block_lin(p);
  for (int v = lin; v < nM * nN; v += G) {
    const int tid = opaque_tid();
    int sR[4], sC[4];
    { const int wid = tid >> 6, lane = tid & 63;
#pragma unroll
      for (int i = 0; i < 4; ++i) stage_rc(wid * 1024 + i * 8192 + lane * 16, sR[i], sC[i]); }
    int pm, pn; tile_map(v, nM, nN, pm, pn);
    const MTile mt = mtile_conv(pm);
    u32 voffA[2], voffB[2];
#pragma unroll
    for (int i = 0; i < 2; ++i) { voffA[i] = (u32)(sR[i] * 1024 + sC[i]) * 2u; voffB[i] = voffA[i]; }
    f32x4 acc[2][2][4][2];
    gemm_tile8p(acc, A + (long)(mt.base + mt.ts) * 1024, (size_t)128 * 1024, voffA, B + (size_t)pn * 256 * 1024, (size_t)128 * 1024, voffB, 16, tid);
    asm volatile("" ::: "memory");
    const int tide = opaque_tid();
    const int wid = tide >> 6, lane = tide & 63, wr = wid >> 2, wc = wid & 3, fr = lane & 15, fq = lane >> 4; (void)wid; (void)lane;
    const int cond = row_cond(mt.base);
    const float* sWc = sW + ((size_t)layer * 5 + cond) * 5632 + pn * 256 + wc * 32 + fq * 4;
    f32x4 s4[2][2];
#pragma unroll
    for (int bj = 0; bj < 2; ++bj)
#pragma unroll
      for (int n = 0; n < 2; ++n) s4[bj][n] = *(const f32x4*)(sWc + bj * 128 + n * 16);
#pragma unroll
    for (int ai = 0; ai < 2; ++ai)
#pragma unroll
      for (int m = 0; m < 4; ++m) {
        const int lr = ai * 128 + wr * 64 + m * 16 + fr, g = mt_grow(mt, lr);
        const float rinv = rsqrtf((rsq[g] + rsq[NTOK + g] + rsq[2 * NTOK + g] + rsq[3 * NTOK + g]) * (1.f / 1024.f) + EPSF);
#pragma unroll
        for (int bj = 0; bj < 2; ++bj)
#pragma unroll
          for (int n = 0; n < 2; ++n) {
            f32x4 t = acc[ai][bj][m][n] * rinv + s4[bj][n];
            u32x2 o; o[0] = pk_bf16(t[0], t[1]); o[1] = pk_bf16(t[2], t[3]);
            *(u32x2*)(g_shm + lr * 544 + (bj * 128 + wc * 32 + n * 16 + fq * 4) * 2) = o;
          }
        asm volatile("" ::: "memory");
      }
    __syncthreads();
    {
      const int cc = tide & 15, rg = tide >> 4, lr0 = rg * 8;
      float w0[8], w1[8], w2[8];
#pragma unroll
      for (int e = 0; e < 8; ++e) { int col = pn * 128 + cc * 8 + e; w0[e] = cw[col]; w1[e] = cw[2816 + col]; w2[e] = cw[2 * 2816 + col]; }
      float prev[8], cur[8], nxt[8];
      ct_load8z(mt, lr0 - 1, cc * 16, prev); ct_load8z(mt, lr0, cc * 16, cur);
#pragma unroll 4
      for (int i = 0; i < 8; ++i) {
        const int lr = lr0 + i;
        ct_load8z(mt, lr + 1, cc * 16, nxt);
        if (lr >= mt.lo && lr < mt.hi) {
          float up[8], o[8];
          ct_load8(lr, 256 + cc * 16, up);
#pragma unroll
          for (int e = 0; e < 8; ++e) { float u = w0[e] * prev[e] + w1[e] * cur[e] + w2[e] * nxt[e]; o[e] = silu_f(u) * up[e]; }
          *(u32x4*)(ACT + (size_t)mt_grow(mt, lr) * 2816 + pn * 128 + cc * 8) = pack8(o);
        }
#pragma unroll
        for (int e = 0; e < 8; ++e) { prev[e] = cur[e]; cur[e] = nxt[e]; }
      }
    }
    __syncthreads();
  }
}

__device__ __forceinline__ void gemm_resid(const P& p, int mode, int layer, const bf16_t* A, int lda, const bf16_t* Bw, int ldb, int nk, bf16_t* A2) {
  const float* mod = (const float*)(p.ws + OFF_MOD);
  float* rsq = (float*)(p.ws + OFF_RSQ);
  const bf16_t* X = (const bf16_t*)p.out;
  bf16_t* Xout = (mode == 1 && layer == 1) ? (bf16_t*)(p.ws + OFF_R1) : (bf16_t*)p.out;
  const int nM = 96, nN = 4, G = GRIDX(), lin = block_lin(p);
  const int ntiles = nM * nN, nfull = (ntiles / G) * G, nrem = ntiles - nfull;
  const bool split = nrem > 0 && 2 * nrem <= G;
  auto epi_rows = [&](int pn, size_t growbase, const float* mc, int wid, int lane) {
    const int ccol = pn * 256 + lane * 4;
    const f32x4 gvn = *(const f32x4*)(mc + (mode == 1 ? 5 : 2) * 1024 + ccol);
    f32x4 gsn = gvn, csn = gvn;
    if (mode != 1) { f32x4 ng = *(const f32x4*)(p.norm_ffn_g + layer * 1024 + ccol), sc = *(const f32x4*)(mc + 4 * 1024 + ccol); gsn = ng * (sc + 1.f); }
    if (mode == 2) csn = *(const f32x4*)(p.pool_scale + ccol);
    u32x2 xrow[16];
#pragma unroll
    for (int r = 0; r < 16; ++r) xrow[r] = *(const u32x2*)(X + (growbase + wid * 16 + r) * 1024 + ccol);
#pragma unroll
    for (int r = 0; r < 16; ++r) {
      const int lrow = wid * 16 + r; const size_t grow = growbase + lrow;
      f32x4 y = *(const f32x4*)(g_shm + lrow * 1088 + lane * 16);
      if (mode == 2) y = y * csn;
      const u32x2 xr = xrow[r];
      f32x4 x = (f32x4){bf_lo(xr[0]), bf_hi(xr[0]), bf_lo(xr[1]), bf_hi(xr[1])};
      x = x + gvn * y;
      { u32x2 xo; xo[0] = pk_bf16(x[0], x[1]); xo[1] = pk_bf16(x[2], x[3]); *(u32x2*)(Xout + grow * 1024 + ccol) = xo; }
      if (mode != 1) { f32x4 a = x * gsn; u32x2 o; o[0] = pk_bf16(a[0], a[1]); o[1] = pk_bf16(a[2], a[3]); *(u32x2*)(A2 + grow * 1024 + ccol) = o; }
      const float ss = wave_sum(x[0] * x[0] + x[1] * x[1] + x[2] * x[2] + x[3] * x[3]);
      if (lane == 0) rsq[(size_t)pn * NTOK + grow] = ss;
    }
  };
  for (int v = lin;; v += G) {
    const int tid = opaque_tid();
    int sR[4], sC[4];
    { const int wid = tid >> 6, lane = tid & 63;
#pragma unroll
      for (int i = 0; i < 4; ++i) stage_rc(wid * 1024 + i * 8192 + lane * 16, sR[i], sC[i]); }
    int tile, mh = -1;
    if (!split || v < nfull) { if (v >= ntiles) break; tile = v; }
    else { const int u = v - nfull; if (u >= 2 * nrem) break; tile = nfull + (u >> 1); mh = u & 1; }
    int pm, pn; tile_map(tile, nM, nN, pm, pn);
    const float* mc = mod + ((size_t)layer * 5 + row_cond(pm * 256)) * 6144;
    if (mh < 0) {
      u32 voffA[2], voffB[2];
#pragma unroll
      for (int i = 0; i < 2; ++i) { voffA[i] = (u32)(sR[i] * lda + sC[i]) * 2u; voffB[i] = (u32)(sR[i] * ldb + sC[i]) * 2u; }
      f32x4 acc[2][2][4][2];
      gemm_tile8p(acc, A + (size_t)pm * 256 * lda + (mode == 2 ? pn * 256 : 0), (size_t)128 * lda, voffA,
                  Bw + (mode == 2 ? (size_t)pn * 65536 : (size_t)pn * 256 * ldb), (size_t)128 * ldb, voffB, nk, tid);
      asm volatile("" ::: "memory");
    const int tide = opaque_tid();
    const int wid = tide >> 6, lane = tide & 63, wr = wid >> 2, wc = wid & 3, fr = lane & 15, fq = lane >> 4; (void)wid; (void)lane;
#pragma unroll
      for (int hf = 0; hf < 2; ++hf) {
#pragma unroll
        for (int bj = 0; bj < 2; ++bj)
#pragma unroll
          for (int m = 0; m < 4; ++m)
#pragma unroll
            for (int n = 0; n < 2; ++n) *(f32x4*)(g_shm + (wr * 64 + m * 16 + fr) * 1088 + (bj * 128 + wc * 32 + n * 16 + fq * 4) * 4) = acc[hf][bj][m][n];
        __syncthreads();
        epi_rows(pn, (size_t)pm * 256 + hf * 128, mc, wid, lane);
        __syncthreads();
      }
    } else {
      u32 aoff[4], boff[4];
#pragma unroll
      for (int i = 0; i < 4; ++i) {
        aoff[i] = (u32)(pm * 256 + (mh > 0 ? 128 : 0) + sR[i]) * (u32)lda + sC[i] + (mode == 2 ? pn * 256 : 0);
        boff[i] = (mode == 2 ? (u32)pn * 65536u + (u32)sR[i] * 256u : (u32)(pn * 256 + sR[i]) * (u32)ldb) + sC[i];
      }
      f32x4 acc[4][4];
      gemm_tile<4>(acc, A, aoff, Bw, boff, nk, tid);
      asm volatile("" ::: "memory");
    const int tide = opaque_tid();
    const int wid = tide >> 6, lane = tide & 63, wr = wid >> 2, wc = wid & 3, fr = lane & 15, fq = lane >> 4; (void)wid; (void)lane;
#pragma unroll
      for (int m = 0; m < 4; ++m)
#pragma unroll
        for (int n = 0; n < 4; ++n) *(f32x4*)(g_shm + (wr * 64 + m * 16 + fr) * 1088 + (wc * 64 + n * 16 + fq * 4) * 4) = acc[m][n];
      __syncthreads();
      epi_rows(pn, (size_t)pm * 256 + mh * 128, mc, wid, lane);
      __syncthreads();
    }
  }
}

template <bool REV>
__device__ __forceinline__ void tri_solve(const float* Mp, float* Tl, int lane, bf16_t* Tg) {
  auto Mrow4 = [&](int i, int j) -> f32x4 {
    if (REV) { const f32x4 v = *(const f32x4*)(Mp + (63 - i) * 64 + 60 - j); return (f32x4){v[3], v[2], v[1], v[0]}; }
    return *(const f32x4*)(Mp + i * 64 + j);
  };
  auto M1 = [&](int i, int j) -> float { return REV ? Mp[(63 - i) * 64 + (63 - j)] : Mp[i * 64 + j]; };
  for (int g = 0; g < 16; ++g) {
    const int i0 = 4 * g;
    float a0 = (i0 == lane) ? 1.f : 0.f, a1 = (i0 + 1 == lane) ? 1.f : 0.f, a2 = (i0 + 2 == lane) ? 1.f : 0.f, a3 = (i0 + 3 == lane) ? 1.f : 0.f;
#pragma unroll 2
    for (int j = 0; j < i0; j += 4) {
      const float t0 = Tl[j * 64 + lane], t1 = Tl[(j + 1) * 64 + lane], t2 = Tl[(j + 2) * 64 + lane], t3 = Tl[(j + 3) * 64 + lane];
      const f32x4 m0 = Mrow4(i0, j), m1 = Mrow4(i0 + 1, j), m2 = Mrow4(i0 + 2, j), m3 = Mrow4(i0 + 3, j);
      a0 -= (m0[0] * t0 + m0[1] * t1) + (m0[2] * t2 + m0[3] * t3);
      a1 -= (m1[0] * t0 + m1[1] * t1) + (m1[2] * t2 + m1[3] * t3);
      a2 -= (m2[0] * t0 + m2[1] * t1) + (m2[2] * t2 + m2[3] * t3);
      a3 -= (m3[0] * t0 + m3[1] * t1) + (m3[2] * t2 + m3[3] * t3);
    }
    const float T0 = a0;
    const float T1 = a1 - M1(i0 + 1, i0) * T0;
    const float T2 = a2 - (M1(i0 + 2, i0) * T0 + M1(i0 + 2, i0 + 1) * T1);
    const float T3 = a3 - (M1(i0 + 3, i0) * T0 + M1(i0 + 3, i0 + 1) * T1 + M1(i0 + 3, i0 + 2) * T2);
    Tl[i0 * 64 + lane] = T0; Tl[(i0 + 1) * 64 + lane] = T1; Tl[(i0 + 2) * 64 + lane] = T2; Tl[(i0 + 3) * 64 + lane] = T3;
    const float tv[4] = {T0, T1, T2, T3};
#pragma unroll
    for (int r = 0; r < 4; ++r) {
      const int i = i0 + r;
      const bf16_t v = (bf16_t)(pk_bf16(tv[r], 0.f) & 0xffffu);
      if (REV) { if (i > lane) Tg[(63 - i) * 64 + (63 - lane)] = v; }
      else { if (i >= lane) Tg[i * 64 + lane] = v; }
    }
  }
}

__device__ __forceinline__ void phase3(const P& p) {
  const int tid = opaque_tid(), sub = tid >> 8, t = tid & 255, w = t >> 6, lane = tid & 63, fr = lane & 15, fq = lane >> 4;
  char* sm = g_shm + sub * 69632;
  char* sk = sm;
  char* sq = sm + 17408;
  float* KK = (float*)(sm + 34816);
  float* QK = (float*)(sm + 51200);
  float* sc = (float*)(sm + 67584);
  const bf16_t* Q = (const bf16_t*)(p.ws + OFF_Q); const bf16_t* K = (const bf16_t*)(p.ws + OFF_K);
  const float* gb = (const float*)(p.ws + OFF_G); const float* bb = (const float*)(p.ws + OFF_BETA);
  bf16_t* Tp = (bf16_t*)(p.ws + OFF_TP); bf16_t* Ap = (bf16_t*)(p.ws + OFF_AP);
  u32x4 pk[4], pq[4];
  auto issue = [&](int it_) {
    const int item_ = it_ * 2 + sub, row0_ = (item_ >> 2) * 64, h_ = item_ & 3;
#pragma unroll
    for (int i = 0; i < 4; ++i) {
      int idx = t + 256 * i, r = idx >> 4, cc = idx & 15;
      pk[i] = *(const u32x4*)(K + (size_t)(row0_ + r) * 512 + h_ * 128 + cc * 8);
      pq[i] = *(const u32x4*)(Q + (size_t)(row0_ + r) * 512 + h_ * 128 + cc * 8);
    }
  };
  if (BIDX() < 768) issue(BIDX());
  for (int it = BIDX(); it < 768; it += GRIDX()) {
    const int item = it * 2 + sub, ch = item >> 2, h = item & 3, row0 = ch * 64;
#pragma unroll
    for (int i = 0; i < 4; ++i) {
      int idx = t + 256 * i, r = idx >> 4, cc = idx & 15;
      *(u32x4*)(sk + r * 272 + cc * 16) = pk[i];
      *(u32x4*)(sq + r * 272 + cc * 16) = pq[i];
    }
    if (t < 64) {
      float g = gb[(size_t)(row0 + t) * 8 + h];
g = wave_prefix(g, lane);
      sc[t] = g; sc[128 + t] = bb[(size_t)(row0 + t) * 8 + h];
    } else if (t < 128) {
      const int i = 63 - lane;
      float g = gb[(size_t)(row0 + i) * 8 + 4 + h];
g = wave_prefix(g, lane);
      sc[64 + i] = g; sc[192 + i] = bb[(size_t)(row0 + i) * 8 + 4 + h];
    }
    __syncthreads();
    {
      f32x4 a1[4], a2[4];
#pragma unroll
      for (int n = 0; n < 4; ++n) { a1[n] = (f32x4){0.f, 0.f, 0.f, 0.f}; a2[n] = a1[n]; }
#pragma unroll
      for (int ks = 0; ks < 4; ++ks) {
        bf16x8 ak = *(const bf16x8*)(sk + (16 * w + fr) * 272 + (ks * 32 + fq * 8) * 2);
        bf16x8 aq = *(const bf16x8*)(sq + (16 * w + fr) * 272 + (ks * 32 + fq * 8) * 2);
#pragma unroll
        for (int n = 0; n < 4; ++n) {
          bf16x8 b = *(const bf16x8*)(sk + (16 * n + fr) * 272 + (ks * 32 + fq * 8) * 2);
          a1[n] = __builtin_amdgcn_mfma_f32_16x16x32_bf16(ak, b, a1[n], 0, 0, 0);
          a2[n] = __builtin_amdgcn_mfma_f32_16x16x32_bf16(aq, b, a2[n], 0, 0, 0);
        }
      }
#pragma unroll
      for (int n = 0; n < 4; ++n)
#pragma unroll
        for (int j = 0; j < 4; ++j) {
          const int c = 16 * w + fq * 4 + j, s = 16 * n + fr;
          float mval, aval;
          if (s < c) { float d = __expf(sc[c] - sc[s]); mval = sc[128 + c] * a1[n][j] * d; aval = a2[n][j] * d; }
          else if (s > c) { float d = __expf(sc[64 + c] - sc[64 + s]); mval = sc[192 + c] * a1[n][j] * d; aval = a2[n][j] * d; }
          else { mval = 0.f; aval = a2[n][j]; }
          KK[c * 64 + s] = mval; QK[c * 64 + s] = aval;
        }
    }
    __syncthreads();
    if (it + GRIDX() < 768) issue(it + GRIDX());
    const int role = sub ? (w ^ 2) : w;
    if (role == 0) tri_solve<false>(KK, (float*)sk, lane, Tp + (size_t)item * 4096);
    else if (role == 1) tri_solve<true>(KK, (float*)sk + 4096, lane, Tp + (size_t)item * 4096);
    else {
      const int u = sub ? t : t - 128;
#pragma unroll
      for (int i = 0; i < 4; ++i) {
        int idx = u + 128 * i; float o[8];
#pragma unroll
        for (int e = 0; e < 8; ++e) o[e] = QK[idx * 8 + e];
        *(u32x4*)(Ap + (size_t)item * 4096 + idx * 8) = pack8(o);
      }
    }
    __syncthreads();
  }
}

constexpr int S_KT = 0, S_VT = 36864, S_ST = 46080, S_RT = 54784, S_VN = 59392, S_VNS = 64000, S_OT = 68608, S_SC = 78848;
constexpr int D_KT = 18432, D_VT = 4608, D_OT = 5120, D_SC = 1024;

__device__ __forceinline__ u32x4 mask_frag(u32x4 v, int r, int c0, int dir, bool unit_diag) {
#pragma unroll
  for (int e = 0; e < 4; ++e) {
    const int ca = c0 + 2 * e, cb = ca + 1;
    u32 lo = v[e] & 0xffffu, hi = v[e] >> 16;
    const bool ka = dir ? (ca > r) : (ca < r), kb = dir ? (cb > r) : (cb < r);
    if (!ka) lo = (ca == r) ? (unit_diag ? 0x3f80u : lo) : 0u;
    if (!kb) hi = (cb == r) ? (unit_diag ? 0x3f80u : hi) : 0u;
    v[e] = lo | (hi << 16);
  }
  return v;
}

__device__ __forceinline__ void scan_item(const P& p, int item) {
  const int tid = opaque_tid(), w = tid >> 6, lane = tid & 63, fr = lane & 15, fq = lane >> 4;
  int seqbase, nchunk, sidx, rem; bool lat;
  if (item < 128) { lat = true; sidx = item >> 5; rem = item & 31; seqbase = NCTX + sidx * 4096; nchunk = 64; }
  else { lat = false; const int u = item - 128; sidx = u >> 5; rem = u & 31; seqbase = sidx * 256; nchunk = 4; }
  const int h = rem >> 3, dir = (rem >> 2) & 1, q4 = rem & 3, dvoff = h * 128 + q4 * 32;
  const bf16_t* Q = (const bf16_t*)(p.ws + OFF_Q); const bf16_t* K = (const bf16_t*)(p.ws + OFF_K); const bf16_t* V = (const bf16_t*)(p.ws + OFF_V);
  const float* gb = (const float*)(p.ws + OFF_G); const float* bb = (const float*)(p.ws + OFF_BETA);
  const bf16_t* Tp = (const bf16_t*)(p.ws + OFF_TP); const bf16_t* Ap = (const bf16_t*)(p.ws + OFF_AP);
  bf16_t* obuf = dir == 0 ? (bf16_t*)(p.ws + OFF_CAT) : (bf16_t*)(p.ws + OFF_OB);
  const int old_ = dir == 0 ? 1024 : 512;
  f32x4 S[2];
  if (lat) {
    const float* s0 = p.state + (((size_t)sidx * 2 + dir) * 4 + h) * 16384;
#pragma unroll
    for (int n = 0; n < 2; ++n)
#pragma unroll
      for (int j = 0; j < 4; ++j) S[n][j] = s0[(16 * w + fq * 4 + j) * 128 + q4 * 32 + n * 16 + fr];
  } else {
#pragma unroll
    for (int n = 0; n < 2; ++n) S[n] = (f32x4){0.f, 0.f, 0.f, 0.f};
  }
#pragma unroll
  for (int n = 0; n < 2; ++n) {
    u32x2 o; o[0] = pk_bf16(S[n][0], S[n][1]); o[1] = pk_bf16(S[n][2], S[n][3]);
    *(u32x2*)(g_shm + S_ST + (n * 16 + fr) * 272 + (16 * w + fq * 4) * 2) = o;
  }
  u32x4 na[4], nt[2], nat[2];
  u32x4 pk[2], pv;
  float pg = 0.f, pb = 0.f;
  const int arow = 16 * (w & 3) + fr;
  auto issue_loads = [&](int cidx) {
    const int row0 = seqbase + cidx * 64; const size_t pit = ((size_t)(row0 >> 6) * 4 + h) * 4096;
    const bf16_t* ab = (w < 4 ? K : Q) + (size_t)(row0 + arow) * 512 + h * 128 + fq * 8;
#pragma unroll
    for (int ks = 0; ks < 4; ++ks) na[ks] = *(const u32x4*)(ab + ks * 32);
#pragma unroll
    for (int ks = 0; ks < 2; ++ks) { nt[ks] = *(const u32x4*)(Tp + pit + arow * 64 + ks * 32 + fq * 8); nat[ks] = *(const u32x4*)(Ap + pit + arow * 64 + ks * 32 + fq * 8); }
#pragma unroll
    for (int i = 0; i < 2; ++i) pk[i] = *(const u32x4*)(K + (size_t)(row0 + lane) * 512 + h * 128 + (w + 8 * i) * 8);
    pv = *(const u32x4*)(V + (size_t)(row0 + lane) * 512 + dvoff + (w & 3) * 8);
    if (tid < 64) { int i = dir ? 63 - lane : lane; pg = gb[(size_t)(row0 + i) * 8 + dir * 4 + h]; pb = bb[(size_t)(row0 + i) * 8 + dir * 4 + h]; }
  };
  auto store_tiles = [&](int buf) {
    float* scl = (float*)(g_shm + S_SC + buf * D_SC);
#pragma unroll
    for (int i = 0; i < 2; ++i) {
      const int cc = w + 8 * i;
#pragma unroll
      for (int e = 0; e < 4; ++e) {
        *(bf16_t*)(g_shm + S_KT + buf * D_KT + (cc * 8 + 2 * e) * 144 + lane * 2) = (bf16_t)(pk[i][e] & 0xffffu);
        *(bf16_t*)(g_shm + S_KT + buf * D_KT + (cc * 8 + 2 * e + 1) * 144 + lane * 2) = (bf16_t)(pk[i][e] >> 16);
      }
    }
    if (w < 4) {
#pragma unroll
      for (int e = 0; e < 4; ++e) {
        *(bf16_t*)(g_shm + S_VT + buf * D_VT + (w * 8 + 2 * e) * 144 + lane * 2) = (bf16_t)(pv[e] & 0xffffu);
        *(bf16_t*)(g_shm + S_VT + buf * D_VT + (w * 8 + 2 * e + 1) * 144 + lane * 2) = (bf16_t)(pv[e] >> 16);
      }
    }
    if (tid < 64) {
      float g = wave_prefix(pg, lane);
      const float tot = rdlane(g, 63);
      const int i = dir ? 63 - lane : lane;
      scl[i] = __expf(g); scl[64 + i] = __expf(tot - g); scl[128 + i] = pb;
      if (lane == 0) scl[192] = __expf(tot);
    }
  };
  issue_loads(dir ? nchunk - 1 : 0);
  store_tiles(0);
  __syncthreads();
  for (int st = 0; st < nchunk; ++st) {
    const int cidx = dir ? nchunk - 1 - st : st;
    const int row0 = seqbase + cidx * 64, buf = st & 1;
    const float* scl = (const float*)(g_shm + S_SC + buf * D_SC);
    bf16x8 ca[4], ct[2], cat[2];
#pragma unroll
    for (int ks = 0; ks < 4; ++ks) ca[ks] = __builtin_bit_cast(bf16x8, na[ks]);
#pragma unroll
    for (int ks = 0; ks < 2; ++ks) {
      ct[ks] = __builtin_bit_cast(bf16x8, mask_frag(nt[ks], arow, ks * 32 + fq * 8, dir, true));
      cat[ks] = __builtin_bit_cast(bf16x8, mask_frag(nat[ks], arow, ks * 32 + fq * 8, dir, false));
    }
    if (st + 1 < nchunk) issue_loads(dir ? cidx - 1 : cidx + 1);
    f32x4 a1[2];
#pragma unroll
    for (int n = 0; n < 2; ++n) a1[n] = (f32x4){0.f, 0.f, 0.f, 0.f};
#pragma unroll
    for (int ks = 0; ks < 4; ++ks)
#pragma unroll
      for (int n = 0; n < 2; ++n) {
        bf16x8 b = *(const bf16x8*)(g_shm + S_ST + (16 * n + fr) * 272 + (ks * 32 + fq * 8) * 2);
        a1[n] = __builtin_amdgcn_mfma_f32_16x16x32_bf16(ca[ks], b, a1[n], 0, 0, 0);
      }
    if (w < 4) {
      const int t0 = 16 * w + fq * 4;
      const f32x4 eg = *(const f32x4*)(scl + t0), be = *(const f32x4*)(scl + 128 + t0);
#pragma unroll
      for (int n = 0; n < 2; ++n) {
        u32x2 vv = *(const u32x2*)(g_shm + S_VT + buf * D_VT + (n * 16 + fr) * 144 + t0 * 2);
        float r0 = be[0] * (bf_lo(vv[0]) - eg[0] * a1[n][0]), r1 = be[1] * (bf_hi(vv[0]) - eg[1] * a1[n][1]);
        float r2 = be[2] * (bf_lo(vv[1]) - eg[2] * a1[n][2]), r3 = be[3] * (bf_hi(vv[1]) - eg[3] * a1[n][3]);
        u32x2 o; o[0] = pk_bf16(r0, r1); o[1] = pk_bf16(r2, r3);
        *(u32x2*)(g_shm + S_RT + (n * 16 + fr) * 144 + t0 * 2) = o;
      }
    }
    __syncthreads();
    {
      const int mt = w & 3, nn = w >> 2, t0 = mt * 16 + fq * 4;
      f32x4 vn = (f32x4){0.f, 0.f, 0.f, 0.f};
#pragma unroll
      for (int ks = 0; ks < 2; ++ks) {
        bf16x8 b = *(const bf16x8*)(g_shm + S_RT + (nn * 16 + fr) * 144 + (ks * 32 + fq * 8) * 2);
        vn = __builtin_amdgcn_mfma_f32_16x16x32_bf16(ct[ks], b, vn, 0, 0, 0);
      }
      const f32x4 el = *(const f32x4*)(scl + 64 + t0);
      u32x2 o; o[0] = pk_bf16(vn[0], vn[1]); o[1] = pk_bf16(vn[2], vn[3]);
      *(u32x2*)(g_shm + S_VN + (nn * 16 + fr) * 144 + t0 * 2) = o;
      u32x2 o2; o2[0] = pk_bf16(vn[0] * el[0], vn[1] * el[1]); o2[1] = pk_bf16(vn[2] * el[2], vn[3] * el[3]);
      *(u32x2*)(g_shm + S_VNS + (nn * 16 + fr) * 144 + t0 * 2) = o2;
    }
    __syncthreads();
    if (w >= 4) {
      const int t0 = (w - 4) * 16 + fq * 4;
      const f32x4 eg = *(const f32x4*)(scl + t0);
#pragma unroll
      for (int n = 0; n < 2; ++n) a1[n] = a1[n] * eg;
#pragma unroll
      for (int ks = 0; ks < 2; ++ks)
#pragma unroll
        for (int n = 0; n < 2; ++n) {
          bf16x8 b = *(const bf16x8*)(g_shm + S_VN + (n * 16 + fr) * 144 + (ks * 32 + fq * 8) * 2);
          a1[n] = __builtin_amdgcn_mfma_f32_16x16x32_bf16(cat[ks], b, a1[n], 0, 0, 0);
        }
#pragma unroll
      for (int n = 0; n < 2; ++n)
#pragma unroll
        for (int j = 0; j < 4; ++j)
          *(bf16_t*)(g_shm + S_OT + buf * D_OT + (t0 + j) * 80 + (n * 16 + fr) * 2) = (bf16_t)(pk_bf16(a1[n][j], 0.f) & 0xffffu);
    }
    {
      const float gl = scl[192];
#pragma unroll
      for (int n = 0; n < 2; ++n) S[n] = S[n] * gl;
#pragma unroll
      for (int ks = 0; ks < 2; ++ks) {
        bf16x8 a = *(const bf16x8*)(g_shm + S_KT + buf * D_KT + (16 * w + fr) * 144 + (ks * 32 + fq * 8) * 2);
#pragma unroll
        for (int n = 0; n < 2; ++n) {
          bf16x8 b = *(const bf16x8*)(g_shm + S_VNS + (n * 16 + fr) * 144 + (ks * 32 + fq * 8) * 2);
          S[n] = __builtin_amdgcn_mfma_f32_16x16x32_bf16(a, b, S[n], 0, 0, 0);
        }
      }
#pragma unroll
      for (int n = 0; n < 2; ++n) {
        u32x2 o; o[0] = pk_bf16(S[n][0], S[n][1]); o[1] = pk_bf16(S[n][2], S[n][3]);
        *(u32x2*)(g_shm + S_ST + (n * 16 + fr) * 272 + (16 * w + fq * 4) * 2) = o;
      }
    }
    if (st + 1 < nchunk) store_tiles(buf ^ 1);
    __syncthreads();
    __builtin_amdgcn_s_waitcnt(0x0F70); __builtin_amdgcn_sched_barrier(0);
    if (tid < 256) { const int r = tid >> 2, cc = tid & 3;
      *(u32x4*)(obuf + (size_t)(row0 + r) * old_ + dvoff + cc * 8) = *(const u32x4*)(g_shm + S_OT + buf * D_OT + r * 80 + cc * 16); }
  }
  __syncthreads();
  if (!lat) {
    float* dst = p.out + (size_t)NTOK * 1024 + (((size_t)sidx * 2 + dir) * 4 + h) * 16384;
#pragma unroll
    for (int n = 0; n < 2; ++n)
#pragma unroll
      for (int j = 0; j < 4; ++j) dst[(16 * w + fq * 4 + j) * 128 + q4 * 32 + n * 16 + fr] = S[n][j];
  }
}

__device__ __forceinline__ void phase4(const P& p) {
  const int b = BIDX(), G = GRIDX();
  if (G >= 256 && (G & 7) == 0) {
    const int x = b & 7, y = b >> 3;
    if (y < 16) scan_item(p, ((x * 4 + (y >> 2)) << 2) | (y & 3));
    else {
      const int ny = (G >> 3) - 16;
      for (int q = y - 16; q < 128; q += ny)
        scan_item(p, 128 + (((q >> 2) * 8 + x) << 2 | (q & 3)));
    }
    cvt_loop(p, 1216 + b, 5440, G, opaque_tid());
  } else {
    for (int it = b; it < 128 + 1024; it += G) scan_item(p, it);
    cvt_loop(p, 1216 + b, 5440, G, opaque_tid());
  }
}

__device__ __forceinline__ void phase5(const P& p) {
  const int tid = opaque_tid();
  {
    const int lane = tid & 63, wid = tid >> 6;
    float* sh2 = (float*)g_shm;
    const float* mod = (const float*)(p.ws + OFF_MOD);
#pragma unroll 10
    for (int idx = tid; idx < 10240; idx += NTHREADS) { int lc = idx >> 10, k = idx & 1023; sh2[idx] = mod[(size_t)lc * 6144 + 3 * 1024 + k]; }
    __syncthreads();
    const bf16_t* Wgu = (const bf16_t*)(p.ws + OFF_WGU);
    float* sW = (float*)(p.ws + OFF_SW);
    for (int r = BIDX() * 8 + wid; r < 2 * 5632; r += GRIDX() * 8) {
      const int l = r / 5632, n = r % 5632;
      float a[5] = {0.f, 0.f, 0.f, 0.f, 0.f};
#pragma unroll
      for (int i = 0; i < 2; ++i) {
        const int k = i * 512 + lane * 8;
        float w[8]; unpack8(*(const u32x4*)(Wgu + ((size_t)l * 5632 + n) * 1024 + k), w);
#pragma unroll
        for (int c = 0; c < 5; ++c) {
          const float* s = sh2 + (l * 5 + c) * 1024 + k;
#pragma unroll
          for (int e = 0; e < 8; ++e) a[c] += w[e] * s[e];
        }
      }
#pragma unroll
      for (int c = 0; c < 5; ++c) { float v = wave_sum(a[c]); if (lane == 0) sW[((size_t)l * 5 + c) * 5632 + n] = v; }
    }
  }
  bf16_t* CAT = (bf16_t*)(p.ws + OFF_CAT); const bf16_t* OB = (const bf16_t*)(p.ws + OFF_OB); const bf16_t* GS = (const bf16_t*)(p.ws + OFF_GS);
  const int l16 = tid & 15, grp = tid >> 4;
  float gn[8];
#pragma unroll
  for (int e = 0; e < 8; ++e) gn[e] = p.o_norm_g[l16 * 8 + e];
  const int pstep = GRIDX() * 32;
  for (int pr = BIDX() * 32 + grp; pr < NTOK * 4; pr += 2 * pstep) {
    const int pr1 = pr + pstep; const bool has1 = pr1 < NTOK * 4; const int q1 = has1 ? pr1 : pr;
    const int row = pr >> 2, h = pr & 3, row1 = q1 >> 2, h1 = q1 & 3;
    const u32x4 la = *(const u32x4*)(CAT + (size_t)row * 1024 + h * 128 + l16 * 8), lb = *(const u32x4*)(OB + (size_t)row * 512 + h * 128 + l16 * 8), lg = *(const u32x4*)(GS + (size_t)row * 512 + h * 128 + l16 * 8);
    const u32x4 ma = *(const u32x4*)(CAT + (size_t)row1 * 1024 + h1 * 128 + l16 * 8), mb = *(const u32x4*)(OB + (size_t)row1 * 512 + h1 * 128 + l16 * 8), mg = *(const u32x4*)(GS + (size_t)row1 * 512 + h1 * 128 + l16 * 8);
    float a[8], b[8], g[8], c[8], d[8], f[8];
    unpack8(la, a); unpack8(lb, b); unpack8(lg, g); unpack8(ma, c); unpack8(mb, d); unpack8(mg, f);
    float ss = 0.f, st = 0.f;
#pragma unroll
    for (int e = 0; e < 8; ++e) { a[e] += b[e]; ss += a[e] * a[e]; c[e] += d[e]; st += c[e] * c[e]; }
    ss = sum16(ss); st = sum16(st);
    const float ri = rsqrtf(ss * (1.f / 128.f) + EPSF), rj = rsqrtf(st * (1.f / 128.f) + EPSF);
#pragma unroll
    for (int e = 0; e < 8; ++e) { a[e] = a[e] * ri * gn[e] * g[e]; c[e] = c[e] * rj * gn[e] * f[e]; }
    *(u32x4*)(CAT + (size_t)row * 1024 + h * 128 + l16 * 8) = pack8(a);
    if (has1) *(u32x4*)(CAT + (size_t)row1 * 1024 + h1 * 128 + l16 * 8) = pack8(c);
  }
}

__device__ __forceinline__ void phase9(const P& p) {
  const int tid = opaque_tid();
  const bf16_t* X = (const bf16_t*)p.out; const float* rsq = (const float*)(p.ws + OFF_RSQ); const float* mod = (const float*)(p.ws + OFF_MOD);
  bf16_t* MX = (bf16_t*)(p.ws + OFF_R1);
  float* rinv = (float*)g_shm;
  char* XS = g_shm + 256;
  const int c4 = tid & 255, half = tid >> 8;
  const int col = c4 * 4, win = 2 << (col >> 8), hw = win >> 1;
  for (int seg = BIDX(); seg < NTOK / 32; seg += GRIDX()) {
    const int row0 = seg * 32;
    int base, L; if (row0 < NCTX) { base = (row0 >> 8) << 8; L = 256; } else { base = NCTX + (((row0 - NCTX) >> 12) << 12); L = 4096; }
    const int p0 = row0 - base;
    __syncthreads();
#pragma unroll
    for (int i = 0; i < 12; ++i) {
      const int idx = tid + 512 * i, r = idx >> 7, cc = idx & 127, q = p0 - 8 + r;
      u32x4 v = (u32x4){0u, 0u, 0u, 0u};
      if (q >= 0 && q < L) v = *(const u32x4*)(X + (size_t)(base + q) * 1024 + cc * 8);
      *(u32x4*)(XS + r * 2048 + cc * 16) = v;
    }
    if (tid < 64) {
      int q = p0 - 16 + tid;
      if (q >= 0 && q < L) { int g = base + q; rinv[tid] = rsqrtf((rsq[g] + rsq[NTOK + g] + rsq[2 * NTOK + g] + rsq[3 * NTOK + g]) * (1.f / 1024.f) + EPSF); }
      else rinv[tid] = 0.f;
    }
    __syncthreads();
    const float* mc = mod + ((size_t)5 + row_cond(row0)) * 6144;
    f32x4 Gm;
    { f32x4 ng = *(const f32x4*)(p.norm_mix_g + 1024 + col), sc = *(const f32x4*)(mc + 1024 + col); Gm = ng * (sc + 1.f); }
    const int ps = p0 + half * 16;
    auto xn = [&](int q) -> f32x4 {
      const u32x2 xr = *(const u32x2*)(XS + (q - p0 + 8) * 2048 + col * 2);
      return (f32x4){bf_lo(xr[0]), bf_hi(xr[0]), bf_lo(xr[1]), bf_hi(xr[1])} * rinv[q - p0 + 16];
    };
    f32x4 sum = (f32x4){0.f, 0.f, 0.f, 0.f};
    for (int q = ps - hw; q < ps - hw + win; ++q) sum = sum + xn(q);
#pragma unroll 4
    for (int i = 0; i < 16; ++i) {
      const int t = ps + i;
      const int lo = max(t - hw, 0), hi = min(t - hw + win, L);
      const f32x4 xc = xn(t), xo = xn(t - hw), xi = xn(t - hw + win);
      f32x4 m = (sum * (1.f / (float)(hi - lo)) - xc) * Gm;
      u32x2 o; o[0] = pk_bf16(m[0], m[1]); o[1] = pk_bf16(m[2], m[3]);
      *(u32x2*)(MX + (size_t)(base + t) * 1024 + col) = o;
      sum = sum - xo + xi;
    }
  }
}

__device__ __forceinline__ void phase13(const P& p) {
  const int tid = opaque_tid(), lane = tid & 63, wid = tid >> 6;
  const float* rsq = (const float*)(p.ws + OFF_RSQ);
  const bf16_t* XF = (const bf16_t*)(p.ws + OFF_R1);
  const int rstep = GRIDX() * 8;
  for (int row = BIDX() * 8 + wid; row < NTOK; row += 2 * rstep) {
    const int row1 = row + rstep; const bool has1 = row1 < NTOK; const int r1 = has1 ? row1 : row;
    u32x2 xa[4], xb[4];
#pragma unroll
    for (int i = 0; i < 4; ++i) { const int k = i * 256 + lane * 4; xa[i] = *(const u32x2*)(XF + (size_t)row * 1024 + k); xb[i] = *(const u32x2*)(XF + (size_t)r1 * 1024 + k); }
    const float ria = rsqrtf((rsq[row] + rsq[NTOK + row] + rsq[2 * NTOK + row] + rsq[3 * NTOK + row]) * (1.f / 1024.f) + EPSF);
    const float rib = rsqrtf((rsq[r1] + rsq[NTOK + r1] + rsq[2 * NTOK + r1] + rsq[3 * NTOK + r1]) * (1.f / 1024.f) + EPSF);
#pragma unroll
    for (int i = 0; i < 4; ++i) {
      const int k = i * 256 + lane * 4;
      const f32x4 g = *(const f32x4*)(p.final_g + k);
      const f32x4 va = (f32x4){bf_lo(xa[i][0]), bf_hi(xa[i][0]), bf_lo(xa[i][1]), bf_hi(xa[i][1])};
      const f32x4 vb = (f32x4){bf_lo(xb[i][0]), bf_hi(xb[i][0]), bf_lo(xb[i][1]), bf_hi(xb[i][1])};
      *(f32x4*)(p.out + (size_t)row * 1024 + k) = va * ria * g;
      if (has1) *(f32x4*)(p.out + (size_t)row1 * 1024 + k) = vb * rib * g;
    }
  }
}

constexpr int NPHASE = 14;
template <int LO, int HI>
__global__ void __launch_bounds__(NTHREADS, 2) fwd_kernel(P p) {
  p.wv = __builtin_amdgcn_readfirstlane((int)(threadIdx.x >> 6));
  if constexpr (HI - LO > 1) { if (p.phase_lo == 0x7fffffff) cg::this_grid().sync();
    grid_bar_init(p); }
#define PH(k, call) if constexpr (LO <= (k) && (k) < HI) { if constexpr ((k) > LO) { grid_bar(p); } call; }
  PH(0, phase0(p))
  PH(1, phase1(p))
  PH(2, gemm_inproj(p))
  PH(3, phase3(p))
  PH(4, phase4(p))
  PH(5, phase5(p))
  PH(6, gemm_resid(p, 0, 0, (const bf16_t*)(p.ws + OFF_CAT), 1024, (const bf16_t*)(p.ws + OFF_WOUT), 1024, 16, (bf16_t*)(p.ws + OFF_R1)))
  PH(7, gemm_ffn_gu(p, 0, (const bf16_t*)(p.ws + OFF_R1)))
  PH(8, gemm_resid(p, 1, 0, (const bf16_t*)(p.ws + OFF_ACT), 2816, (const bf16_t*)(p.ws + OFF_WDN), 2816, 44, (bf16_t*)(p.ws + OFF_R1)))
  PH(9, phase9(p))
  PH(10, gemm_resid(p, 2, 1, (const bf16_t*)(p.ws + OFF_R1), 1024, (const bf16_t*)(p.ws + OFF_WPOOL), 256, 4, (bf16_t*)(p.ws + OFF_R1)))
  PH(11, gemm_ffn_gu(p, 1, (const bf16_t*)(p.ws + OFF_R1)))
  PH(12, gemm_resid(p, 1, 1, (const bf16_t*)(p.ws + OFF_ACT), 2816, (const bf16_t*)(p.ws + OFF_WDN) + (size_t)1024 * 2816, 2816, 44, (bf16_t*)(p.ws + OFF_R1)))
  PH(13, phase13(p))
#undef PH
}

__global__ void cks_kernel(const u32* ptr, size_t nwords, unsigned long long* slot) {
  unsigned long long s = 0;
  for (size_t i = (size_t)blockIdx.x * blockDim.x + threadIdx.x; i < nwords; i += (size_t)gridDim.x * blockDim.x) s += (unsigned long long)ptr[i] * (unsigned long long)((i & 1023) + 1);
  for (int o = 32; o > 0; o >>= 1) s += __shfl_xor(s, o, 64);
  if ((threadIdx.x & 63) == 0) atomicAdd(slot, s);
}
__global__ void cmp_kernel(const unsigned long long* slots, int nbuf, float* out, int n_y, int n_all) {
  int code = 0;
  for (int b = 0; b < nbuf; ++b) if (slots[b] != slots[64 + b]) { code = b + 1; break; }
  const float c = sqrtf(100.f * (float)code);
  for (int i = blockIdx.x * blockDim.x + threadIdx.x; i < n_all; i += gridDim.x * blockDim.x) out[i] = i < n_y ? c : 0.f;
}

__global__ void sanitize_kernel(float* o, int n) {
  for (int i = blockIdx.x * blockDim.x + threadIdx.x; i < n; i += gridDim.x * blockDim.x) { float v = o[i]; if (!(fabsf(v) < 3.0e38f)) o[i] = 0.f; }
}

extern "C" void kernel_launch(void* const* d_in, const int* in_sizes, int n_in, void* d_out, int out_size, void* d_ws, size_t ws_size, hipStream_t stream) {
  static int grid_blocks = 0;
#if COOP
  const void* kfn = (const void*)fwd_kernel<0, NPHASE>;
#else
  const void* kfns[NPHASE] = {(const void*)fwd_kernel<0, 1>, (const void*)fwd_kernel<1, 2>, (const void*)fwd_kernel<2, 3>, (const void*)fwd_kernel<3, 4>,
                              (const void*)fwd_kernel<4, 5>, (const void*)fwd_kernel<5, 6>, (const void*)fwd_kernel<6, 7>, (const void*)fwd_kernel<7, 8>,
                              (const void*)fwd_kernel<8, 9>, (const void*)fwd_kernel<9, 10>, (const void*)fwd_kernel<10, 11>, (const void*)fwd_kernel<11, 12>,
                              (const void*)fwd_kernel<12, 13>, (const void*)fwd_kernel<13, 14>};
#endif
  if (!grid_blocks) {
    int dev = 0, cus = 0;
    (void)hipGetDevice(&dev);
    (void)hipDeviceGetAttribute(&cus, hipDeviceAttributeMultiprocessorCount, dev);
#if COOP
    (void)hipFuncSetAttribute(kfn, hipFuncAttributeMaxDynamicSharedMemorySize, LDS_BYTES);
    int per_cu = 0;
    (void)hipOccupancyMaxActiveBlocksPerMultiprocessor(&per_cu, kfn, NTHREADS, LDS_BYTES);
    if (per_cu < 1) fprintf(stderr, "occupancy query returned %d\n", per_cu);
#else
    for (int i = 0; i < NPHASE; ++i) (void)hipFuncSetAttribute(kfns[i], hipFuncAttributeMaxDynamicSharedMemorySize, LDS_BYTES);
#endif
    grid_blocks = cus >= 8 ? (cus / 8) * 8 : 256;
  }
  P p{};
  p.x_prompt = (const float*)d_in[0]; p.x_sample = (const float*)d_in[1]; p.state = (const float*)d_in[2]; p.c = (const float*)d_in[3];
  p.c_ctx = (const float*)d_in[4]; p.norm_mix_g = (const float*)d_in[5]; p.norm_ffn_g = (const float*)d_in[6]; p.w_ada = (const float*)d_in[7];
  p.b_ada = (const float*)d_in[8]; p.w_in = (const float*)d_in[9]; p.conv_qkv = (const float*)d_in[10]; p.a_log = (const float*)d_in[11];
  p.dt_bias = (const float*)d_in[12]; p.o_norm_g = (const float*)d_in[13]; p.conv_b = (const float*)d_in[14]; p.w_out = (const float*)d_in[15];
  p.w_pool = (const float*)d_in[16]; p.pool_scale = (const float*)d_in[17]; p.w_gate = (const float*)d_in[18]; p.w_up = (const float*)d_in[19];
  p.ffn_conv = (const float*)d_in[20]; p.w_down = (const float*)d_in[21]; p.final_g = (const float*)d_in[22];
  p.out = (float*)d_out; p.ws = (char*)d_ws; p.nblk = grid_blocks; p.wv = 0;
#if COOP
  p.phase_lo = 0; p.phase_hi = NPHASE;
  void* args[] = {&p};
  (void)hipMemsetAsync((char*)d_ws + OFF_BAR, 0, XCD_BAR_WORDS * 4, stream);
  hipError_t e = hipLaunchCooperativeKernel(kfn, dim3(grid_blocks), dim3(NTHREADS), args, LDS_BYTES, stream);
  if (e != hipSuccess) fprintf(stderr, "cooperative launch failed: %s (grid %d)\n", hipGetErrorString(e), grid_blocks);
#else
  p.phase_lo = 0; p.phase_hi = 1;
  void* args[] = {&p};
#ifdef DBG
  {
    const size_t OFF_DBG = (size_t)255 * 1024 * 1024;
    unsigned long long* slots = (unsigned long long*)((char*)d_ws + OFF_DBG);
    (void)hipMemsetAsync(slots, 0, 4096, stream);
    struct CB { int after; const void* ptr; size_t bytes; };
    char* ws = (char*)d_ws; char* o = (char*)d_out;
    const CB cbs[] = {
      {1, ws + OFF_MOD, (size_t)2 * 5 * 6144 * 4}, {1, ws + OFF_WIN, OFF_SMALL}, {1, ws + OFF_SW, (size_t)2 * 5 * 5632 * 4}, {1, ws + OFF_PE, (size_t)64 * 512 * 4},
      {1, ws + OFF_G, (size_t)NTOK * 32}, {1, ws + OFF_BETA, (size_t)NTOK * 32}, {1, o, (size_t)NTOK * 4096}, {1, ws + OFF_R1, SZ_R1},
      {2, ws + OFF_Q, SZ_QKV}, {2, ws + OFF_K, SZ_QKV}, {2, ws + OFF_V, SZ_QKV}, {2, ws + OFF_GS, SZ_QKV},
      {3, ws + OFF_TP, (size_t)1536 * 8192}, {3, ws + OFF_AP, (size_t)1536 * 8192},
      {4, ws + OFF_OB, SZ_QKV}, {4, o + (size_t)NTOK * 4096, (size_t)32 * 2 * 4 * 16384 * 4},
      {5, ws + OFF_CAT, SZ_R1},
      {6, ws + OFF_R1, SZ_R1}, {6, o, (size_t)NTOK * 4096}, {6, ws + OFF_RSQ, (size_t)4 * NTOK * 4}};
    const int ncb = sizeof(cbs) / sizeof(cbs[0]);
    for (int run = 0; run < 2; ++run) {
      (void)hipMemsetAsync(d_ws, run ? 0xAA : 0x55, OFF_DBG, stream);
      (void)hipMemsetAsync(d_out, run ? 0xAA : 0x55, (size_t)out_size * 4, stream);
      for (int ph = 0; ph <= 6; ++ph) {
        (void)hipLaunchKernel(kfns[ph], dim3(grid_blocks), dim3(NTHREADS), args, LDS_BYTES, stream);
        for (int b = 0; b < ncb; ++b) if (cbs[b].after == ph)
          hipLaunchKernelGGL(cks_kernel, dim3(1024), dim3(256), 0, stream, (const u32*)cbs[b].ptr, cbs[b].bytes / 4, slots + run * 64 + b);
      }
    }
    hipLaunchKernelGGL(cmp_kernel, dim3(1024), dim3(256), 0, stream, (const unsigned long long*)slots, ncb, (float*)d_out, NTOK * 1024, out_size);
  }
#else
  for (int ph = 0; ph <= STOP_AFTER; ++ph) {
    hipError_t e = hipLaunchKernel(kfns[ph], dim3(grid_blocks), dim3(NTHREADS), args, LDS_BYTES, stream);
    if (e != hipSuccess) fprintf(stderr, "launch %d failed: %s\n", ph, hipGetErrorString(e));
  }
#ifdef SANITIZE
  hipLaunchKernelGGL(sanitize_kernel, dim3(1024), dim3(256), 0, stream, (float*)d_out, out_size);
#endif
#endif
#endif
}
```

```cpp
#include <hip/hip_runtime.h>
#include <hip/hip_cooperative_groups.h>
#include <cstdio>
namespace cg = cooperative_groups;

#ifndef COOP
#define COOP 1
#endif
#ifndef STOP_AFTER
#define STOP_AFTER 13
#endif


typedef unsigned short bf16_t;
typedef unsigned int u32;
typedef short bf16x8 __attribute__((ext_vector_type(8)));
typedef float f32x4 __attribute__((ext_vector_type(4)));
typedef u32 u32x4 __attribute__((ext_vector_type(4)));
typedef u32 u32x2 __attribute__((ext_vector_type(2)));

constexpr int NTOK = 24576, NCTX = 8192;
constexpr int NTHREADS = 512;
constexpr float EPSF = 1e-6f;
constexpr int LDS_TILE_BYTES = 256 * 544;
constexpr int LDS_BYTES = LDS_TILE_BYTES + 16;

constexpr size_t OFF_WIN = 0;
constexpr size_t OFF_WOUT = OFF_WIN + (size_t)3584 * 1024 * 2;
constexpr size_t OFF_WPOOL = OFF_WOUT + (size_t)1024 * 1024 * 2;
constexpr size_t OFF_WGU = OFF_WPOOL + (size_t)4 * 256 * 256 * 2;
constexpr size_t OFF_WDN = OFF_WGU + (size_t)2 * 5632 * 1024 * 2;
constexpr size_t OFF_SMALL = OFF_WDN + (size_t)2 * 1024 * 2816 * 2;
constexpr size_t OFF_MOD = OFF_SMALL;
constexpr size_t OFF_SW = OFF_MOD + (size_t)2 * 5 * 6144 * 4;
constexpr size_t OFF_PE = OFF_SW + (size_t)2 * 5 * 5632 * 4;
constexpr size_t OFF_G = OFF_PE + (size_t)64 * 512 * 4;
constexpr size_t OFF_BETA = OFF_G + (size_t)NTOK * 8 * 4;
constexpr size_t OFF_RSQ = OFF_BETA + (size_t)NTOK * 8 * 4;
constexpr size_t OFF_BAR = OFF_RSQ + (size_t)4 * NTOK * 4;
constexpr size_t OFF_R1 = OFF_SMALL + (size_t)4 * 1024 * 1024;
constexpr size_t SZ_R1 = (size_t)NTOK * 1024 * 2;
constexpr size_t OFF_BIG = OFF_R1 + SZ_R1;
constexpr size_t SZ_QKV = (size_t)NTOK * 512 * 2;
constexpr size_t OFF_Q = OFF_BIG, OFF_K = OFF_Q + SZ_QKV, OFF_V = OFF_K + SZ_QKV, OFF_GS = OFF_V + SZ_QKV, OFF_CAT = OFF_GS + SZ_QKV;
constexpr size_t OFF_ACT = OFF_BIG;
constexpr size_t OFF_TP = OFF_R1, OFF_AP = OFF_TP + (size_t)1536 * 4096 * 2, OFF_OB = OFF_AP + (size_t)1536 * 4096 * 2;

struct P {
  const float *x_prompt, *x_sample, *state, *c, *c_ctx, *norm_mix_g, *norm_ffn_g, *w_ada, *b_ada, *w_in, *conv_qkv, *a_log, *dt_bias,
      *o_norm_g, *conv_b, *w_out, *w_pool, *pool_scale, *w_gate, *w_up, *ffn_conv, *w_down, *final_g;
  float* out;
  char* ws;
  int phase_lo, phase_hi;
  int nblk, wv;
};

extern __shared__ __attribute__((aligned(1024))) char g_shm[];

typedef __bf16 bf16x2v __attribute__((ext_vector_type(2)));
typedef float f32x2v __attribute__((ext_vector_type(2)));
__device__ __forceinline__ u32 pk_bf16(float lo, float hi) { f32x2v f = {lo, hi}; bf16x2v b = __builtin_convertvector(f, bf16x2v); return __builtin_bit_cast(u32, b); }
__device__ __forceinline__ float bf_lo(u32 w) { return __uint_as_float(w << 16); }
__device__ __forceinline__ float bf_hi(u32 w) { return __uint_as_float(w & 0xffff0000u); }
__device__ __forceinline__ float bf2f(bf16_t v) { return __uint_as_float(((u32)v) << 16); }
__device__ __forceinline__ float silu_f(float x) { return x * __builtin_amdgcn_rcpf(1.f + __expf(-x)); }
__device__ __forceinline__ float sigm_f(float x) { return __builtin_amdgcn_rcpf(1.f + __expf(-x)); }
__device__ __forceinline__ void unpack8(u32x4 v, float (&o)[8]) {
  o[0] = bf_lo(v[0]); o[1] = bf_hi(v[0]); o[2] = bf_lo(v[1]); o[3] = bf_hi(v[1]);
  o[4] = bf_lo(v[2]); o[5] = bf_hi(v[2]); o[6] = bf_lo(v[3]); o[7] = bf_hi(v[3]);
}
__device__ __forceinline__ u32x4 pack8(const float (&o)[8]) {
  u32x4 v; v[0] = pk_bf16(o[0], o[1]); v[1] = pk_bf16(o[2], o[3]); v[2] = pk_bf16(o[4], o[5]); v[3] = pk_bf16(o[6], o[7]); return v;
}
template <int CTRL> __device__ __forceinline__ float dpp_mov(float v) {
  return __builtin_bit_cast(float, __builtin_amdgcn_update_dpp(0, __builtin_bit_cast(int, v), CTRL, 0xF, 0xF, true));
}
__device__ __forceinline__ float sum16(float v) {
  v += dpp_mov<0xB1>(v);
  v += dpp_mov<0x4E>(v);
  v += dpp_mov<0x141>(v);
  v += dpp_mov<0x140>(v);
  return v;
}
__device__ __forceinline__ float rdlane(float v, int l) { return __builtin_bit_cast(float, __builtin_amdgcn_readlane(__builtin_bit_cast(int, v), l)); }
__device__ __forceinline__ float wave_sum(float v) {
  v = sum16(v);
  return (rdlane(v, 0) + rdlane(v, 16)) + (rdlane(v, 32) + rdlane(v, 48));
}
template <int CTRL, int ROWMASK> __device__ __forceinline__ float dpp_add(float v) {
  return v + __builtin_bit_cast(float, __builtin_amdgcn_update_dpp(0, __builtin_bit_cast(int, v), CTRL, ROWMASK, 0xF, CTRL < 0x140));
}
__device__ __forceinline__ float wave_prefix(float g, int  ) {
  g = dpp_add<0x111, 0xF>(g);
  g = dpp_add<0x112, 0xF>(g);
  g = dpp_add<0x114, 0xF>(g);
  g = dpp_add<0x118, 0xF>(g);
  g = dpp_add<0x142, 0xA>(g);
  g = dpp_add<0x143, 0xC>(g);
  return g;
}
#define GRIDX() (p.nblk)
__device__ __forceinline__ int BIDX() { return (int)blockIdx.x; }
__device__ __forceinline__ int opaque_tid_w(int wv) { unsigned m = ~0u; asm volatile("" : "+s"(m)); int t = (wv << 6) | (int)__builtin_amdgcn_mbcnt_hi(m, __builtin_amdgcn_mbcnt_lo(m, 0u)); asm volatile("" : "+v"(t)); return t; }
#define opaque_tid() opaque_tid_w(p.wv)
__device__ __forceinline__ int row_cond(int row) { return row < NCTX ? 0 : 1 + ((row - NCTX) >> 12); }


#define XB_TMO      128
#define XB_XCNT(j)  (256  + 64 * (j))
#define XB_XSUB(j)  (1280 + 64 * (j))
#define XB_XGEN(j)  (2304 + 64 * (j))
#define XB_TOP      3328
#define XB_TOPGEN   3392
#define XCD_BAR_WORDS 3456
#define XB_SPIN_CAP (1u << 18)
#define LAS __attribute__((address_space(3)))
__device__ __forceinline__ unsigned xb_ld(unsigned* q)              { return __hip_atomic_load(q, __ATOMIC_RELAXED, __HIP_MEMORY_SCOPE_AGENT); }
__device__ __forceinline__ unsigned xb_add(unsigned* q, unsigned v) { return __hip_atomic_fetch_add(q, v, __ATOMIC_RELAXED, __HIP_MEMORY_SCOPE_AGENT); }
__device__ __forceinline__ unsigned xb_xcc_id() { return (unsigned)__builtin_amdgcn_s_getreg((3 << 11) | 20) & 0xFu; }
#define XB_SPIN(cond, bar) do { unsigned _sp = 0; while (cond) { __builtin_amdgcn_s_sleep(1); \
    if ((++_sp & 255u) == 0u) { if (xb_ld(&(bar)[XB_TMO])) break; if (_sp > XB_SPIN_CAP) { atomicAdd(&(bar)[XB_TMO], 1u); break; } } } } while (0)
__device__ __forceinline__ void xb_complete(unsigned* bar, unsigned x, unsigned G, unsigned& nloc, unsigned& nx) {
  unsigned sum, cnt, mine, sp = 0u;
  for (;;) {
    sum = 0u; cnt = 0u; mine = 0u;
#pragma unroll
    for (unsigned j = 0; j < 16; ++j) { const unsigned c = xb_ld(&bar[XB_XCNT(j)]); sum += c; cnt += (c > 0u) ? 1u : 0u; mine = (j == x) ? c : mine; }
    if (sum == G) break;
    __builtin_amdgcn_s_sleep(1);
    if ((++sp & 255u) == 0u) { if (xb_ld(&bar[XB_TMO])) break; if (sp > XB_SPIN_CAP) { atomicAdd(&bar[XB_TMO], 1u); break; } }
  }
  nloc = mine > 0u ? mine : 1u; nx = cnt > 0u ? cnt : 1u;
}
__device__ __forceinline__ void grid_bar_init(const P& p) {
  const int tid = opaque_tid();
  volatile LAS unsigned* st = (volatile LAS unsigned*)(g_shm + LDS_TILE_BYTES);
  if (tid == 0) { st[0] = 0u; st[1] = 0u; (void)xb_add(&((unsigned*)(p.ws + OFF_BAR))[XB_XCNT(xb_xcc_id())], 1u); }
  __syncthreads();
}
__device__ __forceinline__ void grid_bar(const P& p) {
  const int tid = opaque_tid();
  asm volatile("s_waitcnt vmcnt(0)" ::: "memory");
  __syncthreads();
  if (tid == 0) {
    unsigned* bar = (unsigned*)(p.ws + OFF_BAR);
    volatile LAS unsigned* st = (volatile LAS unsigned*)(g_shm + LDS_TILE_BYTES);
    const unsigned x = xb_xcc_id();
    __builtin_amdgcn_s_waitcnt(0);
    unsigned nloc = st[0], nx = st[1];
    if (nloc == 0u) { xb_complete(bar, x, (unsigned)p.nblk, nloc, nx); st[0] = nloc; st[1] = nx; }
    const unsigned old = xb_add(&bar[XB_XSUB(x)], 1u);
    const unsigned gen = old / nloc;
    if (old + 1u == (gen + 1u) * nloc) {
      __builtin_amdgcn_fence(__ATOMIC_RELEASE, "agent");
      asm volatile("s_waitcnt vmcnt(0)" ::: "memory");
      const unsigned og = xb_add(&bar[XB_TOP], 1u);
      const unsigned tg = og / nx;
      if (og + 1u == (tg + 1u) * nx) xb_add(&bar[XB_TOPGEN], 1u);
      else XB_SPIN(xb_ld(&bar[XB_TOPGEN]) == tg, bar);
      __builtin_amdgcn_fence(__ATOMIC_ACQUIRE, "agent");
      xb_add(&bar[XB_XGEN(x)], 1u);
      asm volatile("s_waitcnt vmcnt(0)" ::: "memory");
    } else {
      XB_SPIN(xb_ld(&bar[XB_XGEN(x)]) == gen, bar);
      __builtin_amdgcn_fence(__ATOMIC_ACQUIRE, "agent");
      asm volatile("s_waitcnt vmcnt(0)" ::: "memory");
    }
  }
  __syncthreads();
}

struct CvtTile { const float* src; bf16_t* dst; int ld_src, ld_dst; };
__device__ __forceinline__ CvtTile cvt_desc(const P& p, int t) {
  bf16_t* Win = (bf16_t*)(p.ws + OFF_WIN); bf16_t* Wout = (bf16_t*)(p.ws + OFF_WOUT); bf16_t* Wpool = (bf16_t*)(p.ws + OFF_WPOOL);
  bf16_t* Wgu = (bf16_t*)(p.ws + OFF_WGU); bf16_t* Wdn = (bf16_t*)(p.ws + OFF_WDN);
  CvtTile d;
  if (t < 896) {
    int j = t >> 4, kc = t & 15, sc;
    if (j < 24) sc = j * 64; else { int jj = j - 24, m = jj >> 2, part = jj & 3; sc = (part == 0 ? 2064 : part == 1 ? 2576 : part == 2 ? 3088 : 1536) + m * 64; }
    d.src = p.w_in + (size_t)kc * 64 * 3600 + sc; d.ld_src = 3600; d.dst = Win + (size_t)j * 64 * 1024 + kc * 64; d.ld_dst = 1024;
  } else if (t < 1152) {
    int u = t - 896, j = u >> 4, kc = u & 15;
    d.src = p.w_out + (size_t)kc * 64 * 1024 + j * 64; d.ld_src = 1024; d.dst = Wout + (size_t)j * 64 * 1024 + kc * 64; d.ld_dst = 1024;
  } else if (t < 1216) {
    int u = t - 1152, g = u >> 4, j = (u >> 2) & 3, kc = u & 3;
    d.src = p.w_pool + (size_t)g * 65536 + (size_t)kc * 64 * 256 + j * 64; d.ld_src = 256; d.dst = Wpool + (size_t)g * 65536 + (size_t)j * 64 * 256 + kc * 64; d.ld_dst = 256;
  } else if (t < 4032) {
    int u = t - 1216, l = u / 1408, v = u % 1408, j = v >> 4, kc = v & 15, nt = j >> 2, part = j & 3;
    d.src = (part < 2 ? p.w_gate : p.w_up) + (size_t)l * 1024 * 2816 + (size_t)kc * 64 * 2816 + nt * 128 + (part & 1) * 64; d.ld_src = 2816;
    d.dst = Wgu + (size_t)l * 5632 * 1024 + (size_t)j * 64 * 1024 + kc * 64; d.ld_dst = 1024;
  } else {
    int u = t - 4032, l = u / 704, v = u % 704, j = v / 44, kc = v % 44;
    d.src = p.w_down + (size_t)l * 2816 * 1024 + (size_t)kc * 64 * 1024 + j * 64; d.ld_src = 1024;
    d.dst = Wdn + (size_t)l * 1024 * 2816 + (size_t)j * 64 * 2816 + kc * 64; d.ld_dst = 2816;
  }
  return d;
}
__device__ __forceinline__ void cvt_loop(const P& p, int t, const int tend, const int tstride, const int tid) {
  float* tile = (float*)g_shm;
  const int kk0 = tid >> 4, c4 = tid & 15, wn = tid >> 3, wkc = tid & 7;
  float4 v0, v1;
  if (t < tend) { CvtTile d = cvt_desc(p, t); v0 = *(const float4*)(d.src + (size_t)kk0 * d.ld_src + c4 * 4); v1 = *(const float4*)(d.src + (size_t)(kk0 + 32) * d.ld_src + c4 * 4); }
  while (t < tend) {
    const CvtTile d = cvt_desc(p, t);
    { float* q = tile + kk0 * 65 + c4 * 4; q[0] = v0.x; q[1] = v0.y; q[2] = v0.z; q[3] = v0.w;
      q = tile + (kk0 + 32) * 65 + c4 * 4; q[0] = v1.x; q[1] = v1.y; q[2] = v1.z; q[3] = v1.w; }
    const int tn = t + tstride;
    if (tn < tend) { CvtTile e = cvt_desc(p, tn); v0 = *(const float4*)(e.src + (size_t)kk0 * e.ld_src + c4 * 4); v1 = *(const float4*)(e.src + (size_t)(kk0 + 32) * e.ld_src + c4 * 4); }
    __syncthreads();
    { float o[8];
#pragma unroll
      for (int e = 0; e < 8; ++e) o[e] = tile[(wkc * 8 + e) * 65 + wn];
      *(u32x4*)(d.dst + (size_t)wn * d.ld_dst + wkc * 8) = pack8(o); }
    __syncthreads();
    t = tn;
  }
}

__device__ __forceinline__ void phase0(const P& p) {
  const int tid = opaque_tid();
  float* sl = (float*)g_shm;
  float* red = (float*)(g_shm + 20480);
#pragma unroll
  for (int i = tid; i < 5120; i += NTHREADS) { int c = i >> 10, k = i & 1023; float v = c == 0 ? p.c_ctx[k] : p.c[(c - 1) * 1024 + k]; sl[i] = silu_f(v); }
  __syncthreads();
  float* mod = (float*)(p.ws + OFF_MOD);
  for (int item = BIDX(); item < 256; item += GRIDX()) {
    const int gcol0 = item * 48, layer = gcol0 / 6144, n0 = gcol0 % 6144;
    if (tid < 504) {
      const int cgp = tid % 12, kg = tid / 12;
      float acc[5][4];
#pragma unroll
      for (int c = 0; c < 5; ++c)
#pragma unroll
        for (int e = 0; e < 4; ++e) acc[c][e] = 0.f;
      for (int k0 = kg; k0 < 1024; k0 += 42 * 8) {
        float4 w[8];
#pragma unroll
        for (int u = 0; u < 8; ++u) { const int k = k0 + 42 * u; w[u] = k < 1024 ? *(const float4*)(p.w_ada + ((size_t)layer * 1024 + k) * 6144 + n0 + cgp * 4) : make_float4(0.f, 0.f, 0.f, 0.f); }
#pragma unroll
        for (int u = 0; u < 8; ++u) {
          const int k = k0 + 42 * u;
          if (k < 1024) {
#pragma unroll
            for (int c = 0; c < 5; ++c) { float s = sl[c * 1024 + k]; acc[c][0] += s * w[u].x; acc[c][1] += s * w[u].y; acc[c][2] += s * w[u].z; acc[c][3] += s * w[u].w; }
          }
        }
      }
#pragma unroll
      for (int c = 0; c < 5; ++c)
#pragma unroll
        for (int e = 0; e < 4; ++e) red[(kg * 5 + c) * 48 + cgp * 4 + e] = acc[c][e];
    }
    __syncthreads();
    if (tid < 240) {
      int c = tid / 48, n = tid % 48; float s = 0.f;
      for (int kg = 0; kg < 42; ++kg) s += red[(kg * 5 + c) * 48 + n];
      mod[((size_t)layer * 5 + c) * 6144 + n0 + n] = s + p.b_ada[layer * 6144 + n0 + n];
    }
    __syncthreads();
  }
  cvt_loop(p, BIDX(), 1216, GRIDX(), tid);
  float* pe = (float*)(p.ws + OFF_PE);
  for (int idx = BIDX() * NTHREADS + tid; idx < 32768; idx += GRIDX() * NTHREADS) {
    int pp = idx >> 9, e = idx & 511, ee = e & 255;
    float omega = 1.0f / powf(10000.0f, (float)ee / 256.0f);
    float a = (float)pp * omega;
    pe[idx] = e < 256 ? sinf(a) : cosf(a);
  }
}

__device__ __forceinline__ void phase1(const P& p) {
  const int tid = opaque_tid(), lane = tid & 63, wid = tid >> 6;
  float* wl = (float*)g_shm;
  const float* mod = (const float*)(p.ws + OFF_MOD);
#pragma unroll 16
  for (int idx = tid; idx < 16384; idx += NTHREADS) { int k = idx >> 4, j = idx & 15; wl[j * 1024 + k] = p.w_in[(size_t)k * 3600 + 2048 + j]; }
  __syncthreads();
  const float* pe = (const float*)(p.ws + OFF_PE);
  bf16_t* h0 = (bf16_t*)(p.ws + OFF_R1);
  float* gb = (float*)(p.ws + OFF_G); float* bb = (float*)(p.ws + OFF_BETA);
  f32x4 Gv[4];
#pragma unroll
  for (int i = 0; i < 4; ++i) Gv[i] = *(const f32x4*)(p.norm_mix_g + i * 256 + lane * 4);
  for (int it = BIDX(); it < NTOK / 16; it += GRIDX()) {
    float h[2][16];
    const int rowA = it * 16 + wid * 2;
    const bool lat = rowA >= NCTX;
    const float* src = lat ? p.x_sample + (size_t)(rowA - NCTX) * 1024 : p.x_prompt + (size_t)rowA * 1024;
    const float* mc = mod + (size_t)row_cond(rowA) * 6144;
    f32x4 xv[2][4], scv[4], shv[4];
#pragma unroll
    for (int rr = 0; rr < 2; ++rr)
#pragma unroll
      for (int i = 0; i < 4; ++i) xv[rr][i] = *(const f32x4*)(src + rr * 1024 + i * 256 + lane * 4);
    if (lat) {
#pragma unroll
      for (int rr = 0; rr < 2; ++rr) {
        const int pos = (rowA + rr - NCTX) & 4095, pr = pos >> 6, pc = pos & 63;
#pragma unroll
        for (int i = 0; i < 4; ++i) { const int k = i * 256 + lane * 4; xv[rr][i] = xv[rr][i] + *(const f32x4*)(pe + (k < 512 ? pr * 512 + k : pc * 512 + k - 512)); }
      }
    }
#pragma unroll
    for (int i = 0; i < 4; ++i) { const int k = i * 256 + lane * 4; scv[i] = *(const f32x4*)(mc + 1024 + k); shv[i] = *(const f32x4*)(mc + k); }
#pragma unroll
    for (int rr = 0; rr < 2; ++rr) {
      const int row = rowA + rr;
      float ss = 0.f;
#pragma unroll
      for (int i = 0; i < 4; ++i) {
        const int k = i * 256 + lane * 4; const f32x4 v = xv[rr][i];
        { u32x2 xo; xo[0] = pk_bf16(v[0], v[1]); xo[1] = pk_bf16(v[2], v[3]); *(u32x2*)((bf16_t*)p.out + (size_t)row * 1024 + k) = xo; }
        ss += v[0] * v[0] + v[1] * v[1] + v[2] * v[2] + v[3] * v[3];
      }
      ss = wave_sum(ss);
      const float rinv = rsqrtf(ss * (1.f / 1024.f) + EPSF);
#pragma unroll
      for (int i = 0; i < 4; ++i) {
        const int k = i * 256 + lane * 4;
        const f32x4 hv = xv[rr][i] * rinv * Gv[i] * (scv[i] + 1.f) + shv[i];
        h[rr][i * 4 + 0] = hv[0]; h[rr][i * 4 + 1] = hv[1]; h[rr][i * 4 + 2] = hv[2]; h[rr][i * 4 + 3] = hv[3];
        u32x2 o; o[0] = pk_bf16(hv[0], hv[1]); o[1] = pk_bf16(hv[2], hv[3]);
        *(u32x2*)(h0 + (size_t)row * 1024 + k) = o;
      }
    }
    f32x2v hp[16];
#pragma unroll
    for (int k = 0; k < 16; ++k) hp[k] = (f32x2v){h[0][k], h[1][k]};
    float my0 = 0.f, my1 = 0.f;
#pragma unroll 2
    for (int j = 0; j < 16; ++j) {
      f32x2v ap = {0.f, 0.f};
#pragma unroll
      for (int i = 0; i < 4; ++i) {
        float4 w = *(const float4*)(wl + j * 1024 + i * 256 + lane * 4);
        ap += w.x * hp[i * 4] + w.y * hp[i * 4 + 1];
        ap += w.z * hp[i * 4 + 2] + w.w * hp[i * 4 + 3];
      }
      float a0 = wave_sum(ap[0]), a1 = wave_sum(ap[1]);
      if (lane == j) { my0 = a0; my1 = a1; }
    }
    if (lane < 16) {
#pragma unroll
      for (int rr = 0; rr < 2; ++rr) {
        const int row = it * 16 + wid * 2 + rr; float v = rr ? my1 : my0;
        if (lane < 8) bb[(size_t)row * 8 + lane] = sigm_f(v);
        else {
          int q = lane - 8; float z = v + p.dt_bias[q];
          float sp = z > 20.f ? z : log1pf(__expf(z));
          gb[(size_t)row * 8 + q] = -__expf(p.a_log[q]) * sp;
        }
      }
    }
  }

}

__device__ __forceinline__ int lds_byte(int r, int c) {
  int st = (r >> 4) * 2 + (c >> 5), ob = (r & 15) * 64 + (c & 31) * 2;
  return st * 1024 + (ob ^ (((ob >> 9) & 1) << 5));
}
__device__ __forceinline__ void stage_rc(int b, int& R, int& C) {
  int st = b >> 10, sb = b & 1023, swz = sb ^ (((sb >> 9) & 1) << 5);
  R = (st >> 1) * 16 + swz / 64;
  C = (st & 1) * 32 + (swz % 64) / 2;
}
constexpr int TILE_B = 256 * 64 * 2, STAGE_B = 2 * TILE_B;
#define WAIT_V0() asm volatile("s_waitcnt vmcnt(0)" ::: "memory")

template <int MT>
__device__ __forceinline__ void gemm_tile(f32x4 (&acc)[MT][4], const bf16_t* A, const u32 (&aoff)[4], const bf16_t* B, const u32 (&boff)[4], int nt, int tid) {
  const int wid = tid >> 6, lane = tid & 63, wr = wid >> 2, wc = wid & 3, fr = lane & 15, fq = lane >> 4;
#pragma unroll
  for (int m = 0; m < MT; ++m)
#pragma unroll
    for (int n = 0; n < 4; ++n) acc[m][n] = (f32x4){0.f, 0.f, 0.f, 0.f};
#define GSTAGE(buf, kt) do { _Pragma("unroll") for (int i = 0; i < 4; ++i) { \
    if (i < MT / 2) __builtin_amdgcn_global_load_lds((const u32*)(A + aoff[i] + (kt) * 64), (__attribute__((address_space(3))) u32*)(g_shm + (buf) * STAGE_B + wid * 1024 + i * 8192), 16, 0, 0); \
    __builtin_amdgcn_global_load_lds((const u32*)(B + boff[i] + (kt) * 64), (__attribute__((address_space(3))) u32*)(g_shm + (buf) * STAGE_B + TILE_B + wid * 1024 + i * 8192), 16, 0, 0); } } while (0)
  GSTAGE(0, 0); WAIT_V0(); __syncthreads();
  for (int t = 0; t < nt; ++t) {
    const int cur = t & 1;
    if (t + 1 < nt) GSTAGE(cur ^ 1, t + 1);
    const char* sa = g_shm + cur * STAGE_B; const char* sb = sa + TILE_B;
#pragma unroll
    for (int ks = 0; ks < 2; ++ks) {
      bf16x8 At[MT], Bf[4];
#pragma unroll
      for (int m = 0; m < MT; ++m) At[m] = *(const bf16x8*)(sa + lds_byte(wr * (MT * 16) + m * 16 + fr, ks * 32 + fq * 8));
#pragma unroll
      for (int n = 0; n < 4; ++n) Bf[n] = *(const bf16x8*)(sb + lds_byte(wc * 64 + n * 16 + fr, ks * 32 + fq * 8));
#pragma unroll
      for (int m = 0; m < MT; ++m)
#pragma unroll
        for (int n = 0; n < 4; ++n) acc[m][n] = __builtin_amdgcn_mfma_f32_16x16x32_bf16(Bf[n], At[m], acc[m][n], 0, 0, 0);
      __builtin_amdgcn_sched_barrier(0);
    }
    WAIT_V0(); __syncthreads();
  }
#undef GSTAGE
}


__device__ __forceinline__ void gemm_tile8p(f32x4 (&acc)[2][2][4][2], const bf16_t* A, size_t ahstep, const u32 (&voffA)[2], const bf16_t* B, size_t bhstep, const u32 (&voffB)[2], int nt, int tid) {
  const int wid = tid >> 6, lane = tid & 63, wr = wid >> 2, wc = wid & 3, fr = lane & 15, fq = lane >> 4;
#pragma unroll
  for (int ai = 0; ai < 2; ++ai)
#pragma unroll
    for (int bj = 0; bj < 2; ++bj)
#pragma unroll
      for (int m = 0; m < 4; ++m)
#pragma unroll
        for (int n = 0; n < 2; ++n) acc[ai][bj][m][n] = (f32x4){0.f, 0.f, 0.f, 0.f};
#define P8_SA(b, h) (g_shm + ((b) * 2 + (h)) * 16384)
#define P8_SB(b, h) (g_shm + (4 + (b) * 2 + (h)) * 16384)
#define P8_STA(b, h, kt) do { _Pragma("unroll") for (int _i = 0; _i < 2; ++_i) \
    __builtin_amdgcn_global_load_lds((const u32*)((const char*)(A + (h) * ahstep + (kt) * 64) + voffA[_i]), (__attribute__((address_space(3))) u32*)(P8_SA(b, h) + wid * 1024 + _i * 8192), 16, 0, 0); } while (0)
#define P8_STB(b, h, kt) do { _Pragma("unroll") for (int _i = 0; _i < 2; ++_i) \
    __builtin_amdgcn_global_load_lds((const u32*)((const char*)(B + (h) * bhstep + (kt) * 64) + voffB[_i]), (__attribute__((address_space(3))) u32*)(P8_SB(b, h) + wid * 1024 + _i * 8192), 16, 0, 0); } while (0)
#define P8_LDA(dst, b, h) do { _Pragma("unroll") for (int m = 0; m < 4; ++m) _Pragma("unroll") for (int k = 0; k < 2; ++k) \
    dst[m][k] = *(const bf16x8*)(P8_SA(b, h) + lds_byte(wr * 64 + m * 16 + fr, k * 32 + fq * 8)); } while (0)
#define P8_LDB(dst, b, h) do { _Pragma("unroll") for (int n = 0; n < 2; ++n) _Pragma("unroll") for (int k = 0; k < 2; ++k) \
    dst[n][k] = *(const bf16x8*)(P8_SB(b, h) + lds_byte(wc * 32 + n * 16 + fr, k * 32 + fq * 8)); } while (0)
#define P8_MMA(ai, bj, Af, Bfr) do { __builtin_amdgcn_s_setprio(1); \
    _Pragma("unroll") for (int m = 0; m < 4; ++m) _Pragma("unroll") for (int n = 0; n < 2; ++n) _Pragma("unroll") for (int k = 0; k < 2; ++k) \
      acc[ai][bj][m][n] = __builtin_amdgcn_mfma_f32_16x16x32_bf16(Bfr[n][k], Af[m][k], acc[ai][bj][m][n], 0, 0, 0); \
    __builtin_amdgcn_s_setprio(0); } while (0)
#define P8_WV(n) asm volatile("s_waitcnt vmcnt(" #n ")" ::: "memory")
#define P8_WL(n) asm volatile("s_waitcnt lgkmcnt(" #n ")" ::: "memory")
#define P8_BAR __builtin_amdgcn_s_barrier()
#define P8_SCHED __builtin_amdgcn_sched_barrier(0)
  bf16x8 At[4][2], B0[2][2], B1[2][2];
  __builtin_amdgcn_s_waitcnt(0x0F70);
  P8_STB(0, 0, 0); P8_STA(0, 0, 0); P8_STB(0, 1, 0); P8_STA(0, 1, 0);
  if (wr == 1) P8_BAR;
  P8_WV(4); P8_BAR;
  P8_STB(1, 0, 1); P8_STA(1, 0, 1); P8_STB(1, 1, 1);
  P8_WV(6); P8_BAR;
  for (int t = 0; t < nt - 2; t += 2) {
    P8_LDB(B0, 0, 0); P8_SCHED; P8_LDA(At, 0, 0); P8_STA(1, 1, t + 1);
    P8_WL(8); P8_BAR; P8_WL(0); P8_MMA(0, 0, At, B0); P8_BAR; P8_SCHED;
    P8_LDB(B1, 0, 1); P8_STB(0, 0, t + 2);
    P8_BAR; P8_WL(0); P8_MMA(0, 1, At, B1); P8_BAR;
    P8_LDA(At, 0, 1); P8_STA(0, 0, t + 2);
    P8_BAR; P8_WL(0); P8_MMA(1, 0, At, B0); P8_BAR; P8_SCHED;
    P8_STB(0, 1, t + 2);
    P8_WV(6); P8_BAR; P8_MMA(1, 1, At, B1); P8_BAR;
    P8_LDB(B0, 1, 0); P8_SCHED; P8_LDA(At, 1, 0); P8_STA(0, 1, t + 2);
    P8_WL(8); P8_BAR; P8_WL(0); P8_MMA(0, 0, At, B0); P8_BAR; P8_SCHED;
    P8_LDB(B1, 1, 1); P8_STB(1, 0, t + 3);
    P8_BAR; P8_WL(0); P8_MMA(0, 1, At, B1); P8_BAR;
    P8_LDA(At, 1, 1); P8_STA(1, 0, t + 3);
    P8_BAR; P8_WL(0); P8_MMA(1, 0, At, B0); P8_BAR; P8_SCHED;
    P8_STB(1, 1, t + 3);
    P8_WV(6); P8_BAR; P8_MMA(1, 1, At, B1); P8_BAR;
  }
  { P8_LDB(B0, 0, 0); P8_LDA(At, 0, 0); P8_STA(1, 1, nt - 1);
    P8_BAR; P8_WL(0); P8_MMA(0, 0, At, B0); P8_BAR;
    P8_LDB(B1, 0, 1); P8_BAR; P8_WL(0); P8_MMA(0, 1, At, B1); P8_BAR;
    P8_LDA(At, 0, 1); P8_WV(4); P8_BAR; P8_WL(0); P8_MMA(1, 0, At, B0); P8_MMA(1, 1, At, B1); P8_BAR; }
  { P8_LDB(B0, 1, 0); P8_LDA(At, 1, 0); P8_WV(2); P8_BAR; P8_WL(0); P8_MMA(0, 0, At, B0); P8_BAR;
    P8_LDB(B1, 1, 1); P8_WV(0); P8_BAR; P8_WL(0); P8_MMA(0, 1, At, B1); P8_BAR;
    P8_LDA(At, 1, 1); P8_BAR; P8_WL(0); P8_MMA(1, 0, At, B0); P8_MMA(1, 1, At, B1); P8_BAR; }
  if (wr == 0) P8_BAR;
  __syncthreads();
}

__device__ __forceinline__ void tile_map(int v, int nM, int nN, int& pm, int& pn) {
  int nig = 8 * nN, gid = v / nig, fm = gid * 8, gsz = min(nM - fm, 8);
  pm = fm + (v % nig) % gsz; pn = (v % nig) / gsz;
}
__device__ __forceinline__ int block_lin(const P& p) {
  const int b = BIDX(), G = GRIDX();
  return (b & 7) * (G >> 3) + (b >> 3);
}

struct MTile { int base, L, ts, lo, hi; };
__device__ __forceinline__ MTile mtile_conv(int mt) {
  MTile t;
  if (mt < 32) { t.base = mt * 256; t.L = 256; t.ts = 0; t.lo = 0; t.hi = 256; }
  else { int lt = mt - 32, s = lt / 17, j = lt % 17; t.base = NCTX + s * 4096; t.L = 4096; t.ts = 254 * j - 1; t.lo = 1; t.hi = min(255, 4096 - t.ts); }
  return t;
}
__device__ __forceinline__ int mt_grow(const MTile& t, int lr) { return t.base + min(max(t.ts + lr, 0), t.L - 1); }
__device__ __forceinline__ bool mt_valid(const MTile& t, int lr) { int q = t.ts + lr; return lr >= 0 && lr < 256 && q >= 0 && q < t.L; }

__device__ __forceinline__ void ct_load8(int lr, int colbyte, float (&o)[8]) { unpack8(*(const u32x4*)(g_shm + lr * 544 + colbyte), o); }
__device__ __forceinline__ void ct_load8z(const MTile& t, int lr, int colbyte, float (&o)[8]) {
  if (mt_valid(t, lr)) ct_load8(lr, colbyte, o);
  else {
#pragma unroll
    for (int e = 0; e < 8; ++e) o[e] = 0.f;
  }
}

__device__ __forceinline__ void gemm_inproj(const P& p) {
  const bf16_t* A = (const bf16_t*)(p.ws + OFF_R1); const bf16_t* B = (const bf16_t*)(p.ws + OFF_WIN);
  bf16_t* Q = (bf16_t*)(p.ws + OFF_Q); bf16_t* K = (bf16_t*)(p.ws + OFF_K); bf16_t* V = (bf16_t*)(p.ws + OFF_V);
  bf16_t* GS = (bf16_t*)(p.ws + OFF_GS); bf16_t* CAT = (bf16_t*)(p.ws + OFF_CAT);
  const int nM = 100, nN = 14, G = GRIDX(), lin = block_lin(p);
  for (int v = lin; v < nM * nN; v += G) {
    const int tid = opaque_tid();
    int sR[4], sC[4];
    { const int wid = tid >> 6, lane = tid & 63;
#pragma unroll
      for (int i = 0; i < 4; ++i) stage_rc(wid * 1024 + i * 8192 + lane * 16, sR[i], sC[i]); }
    int pm, pn; tile_map(v, nM, nN, pm, pn);
    const MTile mt = mtile_conv(pm);
    u32 voffA[2], voffB[2];
#pragma unroll
    for (int i = 0; i < 2; ++i) { voffA[i] = (u32)(sR[i] * 1024 + sC[i]) * 2u; voffB[i] = voffA[i]; }
    f32x4 acc[2][2][4][2];
    gemm_tile8p(acc, A + (long)(mt.base + mt.ts) * 1024, (size_t)128 * 1024, voffA, B + (size_t)pn * 256 * 1024, (size_t)128 * 1024, voffB, 16, tid);
    asm volatile("" ::: "memory");
    const int tide = opaque_tid();
    const int wid = tide >> 6, lane = tide & 63, wr = wid >> 2, wc = wid & 3, fr = lane & 15, fq = lane >> 4; (void)wid; (void)lane;
#pragma unroll
    for (int ai = 0; ai < 2; ++ai)
#pragma unroll
      for (int bj = 0; bj < 2; ++bj)
#pragma unroll
        for (int m = 0; m < 4; ++m)
#pragma unroll
          for (int n = 0; n < 2; ++n) {
            const f32x4 a = acc[ai][bj][m][n];
            u32x2 o; o[0] = pk_bf16(a[0], a[1]); o[1] = pk_bf16(a[2], a[3]);
            *(u32x2*)(g_shm + (ai * 128 + wr * 64 + m * 16 + fr) * 544 + (bj * 128 + wc * 32 + n * 16 + fq * 4) * 2) = o;
          }
    __syncthreads();
    if (pn < 6) {
      const int cc = tide & 31, rg = tide >> 5, lr0 = rg * 16;
      float w0[8], w1[8], w2[8];
#pragma unroll
      for (int e = 0; e < 8; ++e) { int col = pn * 256 + cc * 8 + e; w0[e] = p.conv_qkv[col]; w1[e] = p.conv_qkv[1536 + col]; w2[e] = p.conv_qkv[3072 + col]; }
      bf16_t* dst = pn < 2 ? Q : pn < 4 ? K : V;
      const int dcol = (pn & 1) * 256 + cc * 8;
      const float post = pn < 2 ? 0.08838834764831845f : 1.f;
      float prev[8], cur[8], nxt[8];
      ct_load8z(mt, lr0 - 1, cc * 16, prev); ct_load8z(mt, lr0, cc * 16, cur);
#pragma unroll 4
      for (int i = 0; i < 16; ++i) {
        const int lr = lr0 + i;
        ct_load8z(mt, lr + 1, cc * 16, nxt);
        float o[8]; float ss = 0.f;
#pragma unroll
        for (int e = 0; e < 8; ++e) { float u = w0[e] * prev[e] + w1[e] * cur[e] + w2[e] * nxt[e]; o[e] = silu_f(u); ss += o[e] * o[e]; }
        if (pn < 4) {
          ss = sum16(ss);
          const float sc = rsqrtf(ss + EPSF) * post;
#pragma unroll
          for (int e = 0; e < 8; ++e) o[e] *= sc;
        }
        if (lr >= mt.lo && lr < mt.hi) *(u32x4*)(dst + (size_t)mt_grow(mt, lr) * 512 + dcol) = pack8(o);
#pragma unroll
        for (int e = 0; e < 8; ++e) { prev[e] = cur[e]; cur[e] = nxt[e]; }
      }
    } else {
      const int mm = pn - 6, cc = tide & 7, rg = tide >> 3, lr0 = rg * 4;
      float w0[8], w1[8], w2[8];
#pragma unroll
      for (int e = 0; e < 8; ++e) { int col = mm * 64 + cc * 8 + e; w0[e] = p.conv_b[col]; w1[e] = p.conv_b[512 + col]; w2[e] = p.conv_b[1024 + col]; }
      float prev[8], cur[8], nxt[8], t1[8], t2[8];
      ct_load8z(mt, lr0 - 1, 128 + cc * 16, t1); ct_load8z(mt, lr0 - 1, 256 + cc * 16, t2);
#pragma unroll
      for (int e = 0; e < 8; ++e) prev[e] = t1[e] * t2[e];
      ct_load8z(mt, lr0, 128 + cc * 16, t1); ct_load8z(mt, lr0, 256 + cc * 16, t2);
#pragma unroll
      for (int e = 0; e < 8; ++e) cur[e] = t1[e] * t2[e];
#pragma unroll
      for (int i = 0; i < 4; ++i) {
        const int lr = lr0 + i;
        ct_load8z(mt, lr + 1, 128 + cc * 16, t1); ct_load8z(mt, lr + 1, 256 + cc * 16, t2);
#pragma unroll
        for (int e = 0; e < 8; ++e) nxt[e] = t1[e] * t2[e];
        if (lr >= mt.lo && lr < mt.hi) {
          float bg[8], gt[8], o[8], o2[8];
          ct_load8(lr, cc * 16, bg); ct_load8(lr, 384 + cc * 16, gt);
#pragma unroll
          for (int e = 0; e < 8; ++e) { o[e] = bg[e] * (w0[e] * prev[e] + w1[e] * cur[e] + w2[e] * nxt[e]); o2[e] = silu_f(gt[e]); }
          const size_t grow = (size_t)mt_grow(mt, lr);
          *(u32x4*)(CAT + grow * 1024 + 512 + mm * 64 + cc * 8) = pack8(o);
          *(u32x4*)(GS + grow * 512 + mm * 64 + cc * 8) = pack8(o2);
        }
#pragma unroll
        for (int e = 0; e < 8; ++e) { prev[e] = cur[e]; cur[e] = nxt[e]; }
      }
    }
    __syncthreads();
  }
}

__device__ __forceinline__ void gemm_ffn_gu(const P& p, int layer, const bf16_t* A) {
  const bf16_t* B = (const bf16_t*)(p.ws + OFF_WGU) + (size_t)layer * 5632 * 1024;
  bf16_t* ACT = (bf16_t*)(p.ws + OFF_ACT);
  const float* rsq = (const float*)(p.ws + OFF_RSQ);
  const float* sW = (const float*)(p.ws + OFF_SW);
  const float* cw = p.ffn_conv + (size_t)layer * 3 * 2816;
  const int nM = 100, nN = 22, G = GRIDX(), lin = block_lin(p);
  for (int v = lin; v < nM * nN; v += G) {
    const int tid = opaque_tid();
    int sR[4], sC[4];
    { const int wid = tid >> 6, lane = tid & 63;
#pragma unroll
      for (int i = 0; i < 4; ++i) stage_rc(wid * 1024 + i * 8192 + lane * 16, sR[i], sC[i]); }
    int pm, pn; tile_map(v, nM, nN, pm, pn);
    const MTile mt = mtile_conv(pm);
    u32 voffA[2], voffB[2];
#pragma unroll
    for (int i = 0; i < 2; ++i) { voffA[i] = (u32)(sR[i] * 1024 + sC[i]) * 2u; voffB[i] = voffA[i]; }
    f32x4 acc[2][2][4][2];
    gemm_tile8p(acc, A + (long)(mt.base + mt.ts) * 1024, (size_t)128 * 1024, voffA, B + (size_t)pn * 256 * 1024, (size_t)128 * 1024, voffB, 16, tid);
    asm volatile("" ::: "memory");
    const int tide = opaque_tid();
    const int wid = tide >> 6, lane = tide & 63, wr = wid >> 2, wc = wid & 3, fr = lane & 15, fq = lane >> 4; (void)wid; (void)lane;
    const int cond = row_cond(mt.base);
    const float* sWc = sW + ((size_t)layer * 5 + cond) * 5632 + pn * 256 + wc * 32 + fq * 4;
    f32x4 s4[2][2];
#pragma unroll
    for (int bj = 0; bj < 2; ++bj)
#pragma unroll
      for (int n = 0; n < 2; ++n) s4[bj][n] = *(const f32x4*)(sWc + bj * 128 + n * 16);
#pragma unroll
    for (int ai = 0; ai < 2; ++ai)
#pragma unroll
      for (int m = 0; m < 4; ++m) {
        const int lr = ai * 128 + wr * 64 + m * 16 + fr, g = mt_grow(mt, lr);
        const float rinv = rsqrtf((rsq[g] + rsq[NTOK + g] + rsq[2 * NTOK + g] + rsq[3 * NTOK + g]) * (1.f / 1024.f) + EPSF);
#pragma unroll
        for (int bj = 0; bj < 2; ++bj)
#pragma unroll
          for (int n = 0; n < 2; ++n) {
            f32x4 t = acc[ai][bj][m][n] * rinv + s4[bj][n];
            u32x2 o; o[0] = pk_bf16(t[0], t[1]); o[1] = pk_bf16(t[2], t[3]);
            *(u32x2*)(g_shm + lr * 544 + (bj * 128 + wc * 32 + n * 16 + fq * 4) * 2) = o;
          }
        asm volatile("" ::: "memory");
      }
    __syncthreads();
    {
      const int cc = tide & 15, rg = tide >> 4, lr0 = rg * 8;
      float w0[8], w1[8], w2[8];
#pragma unroll
      for (int e = 0; e < 8; ++e) { int col = pn * 128 + cc * 8 + e; w0[e] = cw[col]; w1[e] = cw[2816 + col]; w2[e] = cw[2 * 2816 + col]; }
      float prev[8], cur[8], nxt[8];
      ct_load8z(mt, lr0 - 1, cc * 16, prev); ct_load8z(mt, lr0, cc * 16, cur);
#pragma unroll 4
      for (int i = 0; i < 8; ++i) {
        const int lr = lr0 + i;
        ct_load8z(mt, lr + 1, cc * 16, nxt);
        if (lr >= mt.lo && lr < mt.hi) {
          float up[8], o[8];
          ct_load8(lr, 256 + cc * 16, up);
#pragma unroll
          for (int e = 0; e < 8; ++e) { float u = w0[e] * prev[e] + w1[e] * cur[e] + w2[e] * nxt[e]; o[e] = silu_f(u) * up[e]; }
          *(u32x4*)(ACT + (size_t)mt_grow(mt, lr) * 2816 + pn * 128 + cc * 8) = pack8(o);
        }
#pragma unroll
        for (int e = 0; e < 8; ++e) { prev[e] = cur[e]; cur[e] = nxt[e]; }
      }
    }
    __syncthreads();
  }
}

__device__ __forceinline__ void gemm_resid(const P& p, int mode, int layer, const bf16_t* A, int lda, const bf16_t* Bw, int ldb, int nk, bf16_t* A2) {
  const float* mod = (const float*)(p.ws + OFF_MOD);
  float* rsq = (float*)(p.ws + OFF_RSQ);
  const bf16_t* X = (const bf16_t*)p.out;
  bf16_t* Xout = (mode == 1 && layer == 1) ? (bf16_t*)(p.ws + OFF_R1) : (bf16_t*)p.out;
  const int nM = 96, nN = 4, G = GRIDX(), lin = block_lin(p);
  const int ntiles = nM * nN, nfull = (ntiles / G) * G, nrem = ntiles - nfull;
  const bool split = nrem > 0 && 2 * nrem <= G;
  auto epi_rows = [&](int pn, size_t growbase, const float* mc, int wid, int lane) {
    const int ccol = pn * 256 + lane * 4;
    const f32x4 gvn = *(const f32x4*)(mc + (mode == 1 ? 5 : 2) * 1024 + ccol);
    f32x4 gsn = gvn, csn = gvn;
    if (mode != 1) { f32x4 ng = *(const f32x4*)(p.norm_ffn_g + layer * 1024 + ccol), sc = *(const f32x4*)(mc + 4 * 1024 + ccol); gsn = ng * (sc + 1.f); }
    if (mode == 2) csn = *(const f32x4*)(p.pool_scale + ccol);
    u32x2 xrow[16];
#pragma unroll
    for (int r = 0; r < 16; ++r) xrow[r] = *(const u32x2*)(X + (growbase + wid * 16 + r) * 1024 + ccol);
#pragma unroll
    for (int r = 0; r < 16; ++r) {
      const int lrow = wid * 16 + r; const size_t grow = growbase + lrow;
      f32x4 y = *(const f32x4*)(g_shm + lrow * 1088 + lane * 16);
      if (mode == 2) y = y * csn;
      const u32x2 xr = xrow[r];
      f32x4 x = (f32x4){bf_lo(xr[0]), bf_hi(xr[0]), bf_lo(xr[1]), bf_hi(xr[1])};
      x = x + gvn * y;
      { u32x2 xo; xo[0] = pk_bf16(x[0], x[1]); xo[1] = pk_bf16(x[2], x[3]); *(u32x2*)(Xout + grow * 1024 + ccol) = xo; }
      if (mode != 1) { f32x4 a = x * gsn; u32x2 o; o[0] = pk_bf16(a[0], a[1]); o[1] = pk_bf16(a[2], a[3]); *(u32x2*)(A2 + grow * 1024 + ccol) = o; }
      const float ss = wave_sum(x[0] * x[0] + x[1] * x[1] + x[2] * x[2] + x[3] * x[3]);
      if (lane == 0) rsq[(size_t)pn * NTOK + grow] = ss;
    }
  };
  for (int v = lin;; v += G) {
    const int tid = opaque_tid();
    int sR[4], sC[4];
    { const int wid = tid >> 6, lane = tid & 63;
#pragma unroll
      for (int i = 0; i < 4; ++i) stage_rc(wid * 1024 + i * 8192 + lane * 16, sR[i], sC[i]); }
    int tile, mh = -1;
    if (!split || v < nfull) { if (v >= ntiles) break; tile = v; }
    else { const int u = v - nfull; if (u >= 2 * nrem) break; tile = nfull + (u >> 1); mh = u & 1; }
    int pm, pn; tile_map(tile, nM, nN, pm, pn);
    const float* mc = mod + ((size_t)layer * 5 + row_cond(pm * 256)) * 6144;
    if (mh < 0) {
      u32 voffA[2], voffB[2];
#pragma unroll
      for (int i = 0; i < 2; ++i) { voffA[i] = (u32)(sR[i] * lda + sC[i]) * 2u; voffB[i] = (u32)(sR[i] * ldb + sC[i]) * 2u; }
      f32x4 acc[2][2][4][2];
      gemm_tile8p(acc, A + (size_t)pm * 256 * lda + (mode == 2 ? pn * 256 : 0), (size_t)128 * lda, voffA,
                  Bw + (mode == 2 ? (size_t)pn * 65536 : (size_t)pn * 256 * ldb), (size_t)128 * ldb, voffB, nk, tid);
      asm volatile("" ::: "memory");
    const int tide = opaque_tid();
    const int wid = tide >> 6, lane = tide & 63, wr = wid >> 2, wc = wid & 3, fr = lane & 15, fq = lane >> 4; (void)wid; (void)lane;
#pragma unroll
      for (int hf = 0; hf < 2; ++hf) {
#pragma unroll
        for (int bj = 0; bj < 2; ++bj)
#pragma unroll
          for (int m = 0; m < 4; ++m)
#pragma unroll
            for (int n = 0; n < 2; ++n) *(f32x4*)(g_shm + (wr * 64 + m * 16 + fr) * 1088 + (bj * 128 + wc * 32 + n * 16 + fq * 4) * 4) = acc[hf][bj][m][n];
        __syncthreads();
        epi_rows(pn, (size_t)pm * 256 + hf * 128, mc, wid, lane);
        __syncthreads();
      }
    } else {
      u32 aoff[4], boff[4];
#pragma unroll
      for (int i = 0; i < 4; ++i) {
        aoff[i] = (u32)(pm * 256 + (mh > 0 ? 128 : 0) + sR[i]) * (u32)lda + sC[i] + (mode == 2 ? pn * 256 : 0);
        boff[i] = (mode == 2 ? (u32)pn * 65536u + (u32)sR[i] * 256u : (u32)(pn * 256 + sR[i]) * (u32)ldb) + sC[i];
      }
      f32x4 acc[4][4];
      gemm_tile<4>(acc, A, aoff, Bw, boff, nk, tid);
      asm volatile("" ::: "memory");
    const int tide = opaque_tid();
    const int wid = tide >> 6, lane = tide & 63, wr = wid >> 2, wc = wid & 3, fr = lane & 15, fq = lane >> 4; (void)wid; (void)lane;
#pragma unroll
      for (int m = 0; m < 4; ++m)
#pragma unroll
        for (int n = 0; n < 4; ++n) *(f32x4*)(g_shm + (wr * 64 + m * 16 + fr) * 1088 + (wc * 64 + n * 16 + fq * 4) * 4) = acc[m][n];
      __syncthreads();
      epi_rows(pn, (size_t)pm * 256 + mh * 128, mc, wid, lane);
      __syncthreads();
    }
  }
}

template <bool REV>
__device__ __forceinline__ void tri_solve(const float* Mp, float* Tl, int lane, bf16_t* Tg) {
  auto Mrow4 = [&](int i, int j) -> f32x4 {
    if (REV) { const f32x4 v = *(const f32x4*)(Mp + (63 - i) * 64 + 60 - j); return (f32x4){v[3], v[2], v[1], v[0]}; }
    return *(const f32x4*)(Mp + i * 64 + j);
  };
  auto M1 = [&](int i, int j) -> float { return REV ? Mp[(63 - i) * 64 + (63 - j)] : Mp[i * 64 + j]; };
  for (int g = 0; g < 16; ++g) {
    const int i0 = 4 * g;
    float a0 = (i0 == lane) ? 1.f : 0.f, a1 = (i0 + 1 == lane) ? 1.f : 0.f, a2 = (i0 + 2 == lane) ? 1.f : 0.f, a3 = (i0 + 3 == lane) ? 1.f : 0.f;
#pragma unroll 2
    for (int j = 0; j < i0; j += 4) {
      const float t0 = Tl[j * 64 + lane], t1 = Tl[(j + 1) * 64 + lane], t2 = Tl[(j + 2) * 64 + lane], t3 = Tl[(j + 3) * 64 + lane];
      const f32x4 m0 = Mrow4(i0, j), m1 = Mrow4(i0 + 1, j), m2 = Mrow4(i0 + 2, j), m3 = Mrow4(i0 + 3, j);
      a0 -= (m0[0] * t0 + m0[1] * t1) + (m0[2] * t2 + m0[3] * t3);
      a1 -= (m1[0] * t0 + m1[1] * t1) + (m1[2] * t2 + m1[3] * t3);
      a2 -= (m2[0] * t0 + m2[1] * t1) + (m2[2] * t2 + m2[3] * t3);
      a3 -= (m3[0] * t0 + m3[1] * t1) + (m3[2] * t2 + m3[3] * t3);
    }
    const float T0 = a0;
    const float T1 = a1 - M1(i0 + 1, i0) * T0;
    const float T2 = a2 - (M1(i0 + 2, i0) * T0 + M1(i0 + 2, i0 + 1) * T1);
    const float T3 = a3 - (M1(i0 + 3, i0) * T0 + M1(i0 + 3, i0 + 1) * T1 + M1(i0 + 3, i0 + 2) * T2);
    Tl[i0 * 64 + lane] = T0; Tl[(i0 + 1) * 64 + lane] = T1; Tl[(i0 + 2) * 64 + lane] = T2; Tl[(i0 + 3) * 64 + lane] = T3;
    const float tv[4] = {T0, T1, T2, T3};
#pragma unroll
    for (int r = 0; r < 4; ++r) {
      const int i = i0 + r;
      const bf16_t v = (bf16_t)(pk_bf16(tv[r], 0.f) & 0xffffu);
      if (REV) { if (i > lane) Tg[(63 - i) * 64 + (63 - lane)] = v; }
      else { if (i >= lane) Tg[i * 64 + lane] = v; }
    }
  }
}

__device__ __forceinline__ void phase3(const P& p) {
  const int tid = opaque_tid(), sub = tid >> 8, t = tid & 255, w = t >> 6, lane = tid & 63, fr = lane & 15, fq = lane >> 4;
  char* sm = g_shm + sub * 69632;
  char* sk = sm;
  char* sq = sm + 17408;
  float* KK = (float*)(sm + 34816);
  float* QK = (float*)(sm + 51200);
  float* sc = (float*)(sm + 67584);
  const bf16_t* Q = (const bf16_t*)(p.ws + OFF_Q); const bf16_t* K = (const bf16_t*)(p.ws + OFF_K);
  const float* gb = (const float*)(p.ws + OFF_G); const float* bb = (const float*)(p.ws + OFF_BETA);
  bf16_t* Tp = (bf16_t*)(p.ws + OFF_TP); bf16_t* Ap = (bf16_t*)(p.ws + OFF_AP);
  u32x4 pk[4], pq[4];
  auto issue = [&](int it_) {
    const int item_ = it_ * 2 + sub, row0_ = (item_ >> 2) * 64, h_ = item_ & 3;
#pragma unroll
    for (int i = 0; i < 4; ++i) {
      int idx = t + 256 * i, r = idx >> 4, cc = idx & 15;
      pk[i] = *(const u32x4*)(K + (size_t)(row0_ + r) * 512 + h_ * 128 + cc * 8);
      pq[i] = *(const u32x4*)(Q + (size_t)(row0_ + r) * 512 + h_ * 128 + cc * 8);
    }
  };
  if (BIDX() < 768) issue(BIDX());
  for (int it = BIDX(); it < 768; it += GRIDX()) {
    const int item = it * 2 + sub, ch = item >> 2, h = item & 3, row0 = ch * 64;
#pragma unroll
    for (int i = 0; i < 4; ++i) {
      int idx = t + 256 * i, r = idx >> 4, cc = idx & 15;
      *(u32x4*)(sk + r * 272 + cc * 16) = pk[i];
      *(u32x4*)(sq + r * 272 + cc * 16) = pq[i];
    }
    if (t < 64) {
      float g = gb[(size_t)(row0 + t) * 8 + h];
g = wave_prefix(g, lane);
      sc[t] = g; sc[128 + t] = bb[(size_t)(row0 + t) * 8 + h];
    } else if (t < 128) {
      const int i = 63 - lane;
      float g = gb[(size_t)(row0 + i) * 8 + 4 + h];
g = wave_prefix(g, lane);
      sc[64 + i] = g; sc[192 + i] = bb[(size_t)(row0 + i) * 8 + 4 + h];
    }
    __syncthreads();
    {
      f32x4 a1[4], a2[4];
#pragma unroll
      for (int n = 0; n < 4; ++n) { a1[n] = (f32x4){0.f, 0.f, 0.f, 0.f}; a2[n] = a1[n]; }
#pragma unroll
      for (int ks = 0; ks < 4; ++ks) {
        bf16x8 ak = *(const bf16x8*)(sk + (16 * w + fr) * 272 + (ks * 32 + fq * 8) * 2);
        bf16x8 aq = *(const bf16x8*)(sq + (16 * w + fr) * 272 + (ks * 32 + fq * 8) * 2);
#pragma unroll
        for (int n = 0; n < 4; ++n) {
          bf16x8 b = *(const bf16x8*)(sk + (16 * n + fr) * 272 + (ks * 32 + fq * 8) * 2);
          a1[n] = __builtin_amdgcn_mfma_f32_16x16x32_bf16(ak, b, a1[n], 0, 0, 0);
          a2[n] = __builtin_amdgcn_mfma_f32_16x16x32_bf16(aq, b, a2[n], 0, 0, 0);
        }
      }
#pragma unroll
      for (int n = 0; n < 4; ++n)
#pragma unroll
        for (int j = 0; j < 4; ++j) {
          const int c = 16 * w + fq * 4 + j, s = 16 * n + fr;
          float mval, aval;
          if (s < c) { float d = __expf(sc[c] - sc[s]); mval = sc[128 + c] * a1[n][j] * d; aval = a2[n][j] * d; }
          else if (s > c) { float d = __expf(sc[64 + c] - sc[64 + s]); mval = sc[192 + c] * a1[n][j] * d; aval = a2[n][j] * d; }
          else { mval = 0.f; aval = a2[n][j]; }
          KK[c * 64 + s] = mval; QK[c * 64 + s] = aval;
        }
    }
    __syncthreads();
    if (it + GRIDX() < 768) issue(it + GRIDX());
    const int role = sub ? (w ^ 2) : w;
    if (role == 0) tri_solve<false>(KK, (float*)sk, lane, Tp + (size_t)item * 4096);
    else if (role == 1) tri_solve<true>(KK, (float*)sk + 4096, lane, Tp + (size_t)item * 4096);
    else {
      const int u = sub ? t : t - 128;
#pragma unroll
      for (int i = 0; i < 4; ++i) {
        int idx = u + 128 * i; float o[8];
#pragma unroll
        for (int e = 0; e < 8; ++e) o[e] = QK[idx * 8 + e];
        *(u32x4*)(Ap + (size_t)item * 4096 + idx * 8) = pack8(o);
      }
    }
    __syncthreads();
  }
}

constexpr int S_KT = 0, S_VT = 36864, S_ST = 46080, S_RT = 54784, S_VN = 59392, S_VNS = 64000, S_OT = 68608, S_SC = 78848;
constexpr int D_KT = 18432, D_VT = 4608, D_OT = 5120, D_SC = 1024;

__device__ __forceinline__ u32x4 mask_frag(u32x4 v, int r, int c0, int dir, bool unit_diag) {
#pragma unroll
  for (int e = 0; e < 4; ++e) {
    const int ca = c0 + 2 * e, cb = ca + 1;
    u32 lo = v[e] & 0xffffu, hi = v[e] >> 16;
    const bool ka = dir ? (ca > r) : (ca < r), kb = dir ? (cb > r) : (cb < r);
    if (!ka) lo = (ca == r) ? (unit_diag ? 0x3f80u : lo) : 0u;
    if (!kb) hi = (cb == r) ? (unit_diag ? 0x3f80u : hi) : 0u;
    v[e] = lo | (hi << 16);
  }
  return v;
}

__device__ __forceinline__ void scan_item(const P& p, int item) {
  const int tid = opaque_tid(), w = tid >> 6, lane = tid & 63, fr = lane & 15, fq = lane >> 4;
  int seqbase, nchunk, sidx, rem; bool lat;
  if (item < 128) { lat = true; sidx = item >> 5; rem = item & 31; seqbase = NCTX + sidx * 4096; nchunk = 64; }
  else { lat = false; const int u = item - 128; sidx = u >> 5; rem = u & 31; seqbase = sidx * 256; nchunk = 4; }
  const int h = rem >> 3, dir = (rem >> 2) & 1, q4 = rem & 3, dvoff = h * 128 + q4 * 32;
  const bf16_t* Q = (const bf16_t*)(p.ws + OFF_Q); const bf16_t* K = (const bf16_t*)(p.ws + OFF_K); const bf16_t* V = (const bf16_t*)(p.ws + OFF_V);
  const float* gb = (const float*)(p.ws + OFF_G); const float* bb = (const float*)(p.ws + OFF_BETA);
  const bf16_t* Tp = (const bf16_t*)(p.ws + OFF_TP); const bf16_t* Ap = (const bf16_t*)(p.ws + OFF_AP);
  bf16_t* obuf = dir == 0 ? (bf16_t*)(p.ws + OFF_CAT) : (bf16_t*)(p.ws + OFF_OB);
  const int old_ = dir == 0 ? 1024 : 512;
  f32x4 S[2];
  if (lat) {
    const float* s0 = p.state + (((size_t)sidx * 2 + dir) * 4 + h) * 16384;
#pragma unroll
    for (int n = 0; n < 2; ++n)
#pragma unroll
      for (int j = 0; j < 4; ++j) S[n][j] = s0[(16 * w + fq * 4 + j) * 128 + q4 * 32 + n * 16 + fr];
  } else {
#pragma unroll
    for (int n = 0; n < 2; ++n) S[n] = (f32x4){0.f, 0.f, 0.f, 0.f};
  }
#pragma unroll
  for (int n = 0; n < 2; ++n) {
    u32x2 o; o[0] = pk_bf16(S[n][0], S[n][1]); o[1] = pk_bf16(S[n][2], S[n][3]);
    *(u32x2*)(g_shm + S_ST + (n * 16 + fr) * 272 + (16 * w + fq * 4) * 2) = o;
  }
  u32x4 na[4], nt[2], nat[2];
  u32x4 pk[2], pv;
  float pg = 0.f, pb = 0.f;
  const int arow = 16 * (w & 3) + fr;
  auto issue_loads = [&](int cidx) {
    const int row0 = seqbase + cidx * 64; const size_t pit = ((size_t)(row0 >> 6) * 4 + h) * 4096;
    const bf16_t* ab = (w < 4 ? K : Q) + (size_t)(row0 + arow) * 512 + h * 128 + fq * 8;
#pragma unroll
    for (int ks = 0; ks < 4; ++ks) na[ks] = *(const u32x4*)(ab + ks * 32);
#pragma unroll
    for (int ks = 0; ks < 2; ++ks) { nt[ks] = *(const u32x4*)(Tp + pit + arow * 64 + ks * 32 + fq * 8); nat[ks] = *(const u32x4*)(Ap + pit + arow * 64 + ks * 32 + fq * 8); }
#pragma unroll
    for (int i = 0; i < 2; ++i) pk[i] = *(const u32x4*)(K + (size_t)(row0 + (w & 3) * 16 + fr) * 512 + h * 128 + (((w >> 2) + 2 * i) * 4 + fq) * 8);
    pv = *(const u32x4*)(V + (size_t)(row0 + (w & 3) * 16 + fr) * 512 + dvoff + fq * 8);
    if (tid < 64) { int i = dir ? 63 - lane : lane; pg = gb[(size_t)(row0 + i) * 8 + dir * 4 + h]; pb = bb[(size_t)(row0 + i) * 8 + dir * 4 + h]; }
  };
  auto store_tiles = [&](int buf) {
    float* scl = (float*)(g_shm + S_SC + buf * D_SC);
    const int tokk = (w & 3) * 16 + fr;
#pragma unroll
    for (int i = 0; i < 2; ++i) {
      const int cc = ((w >> 2) + 2 * i) * 4 + fq;
#pragma unroll
      for (int e = 0; e < 4; ++e) {
        *(bf16_t*)(g_shm + S_KT + buf * D_KT + (cc * 8 + 2 * e) * 144 + tokk * 2) = (bf16_t)(pk[i][e] & 0xffffu);
        *(bf16_t*)(g_shm + S_KT + buf * D_KT + (cc * 8 + 2 * e + 1) * 144 + tokk * 2) = (bf16_t)(pk[i][e] >> 16);
      }
    }
    if (w < 4) {
#pragma unroll
      for (int e = 0; e < 4; ++e) {
        *(bf16_t*)(g_shm + S_VT + buf * D_VT + (fq * 8 + 2 * e) * 144 + tokk * 2) = (bf16_t)(pv[e] & 0xffffu);
        *(bf16_t*)(g_shm + S_VT + buf * D_VT + (fq * 8 + 2 * e + 1) * 144 + tokk * 2) = (bf16_t)(pv[e] >> 16);
      }
    }
    if (tid < 64) {
      float g = wave_prefix(pg, lane);
      const float tot = rdlane(g, 63);
      const int i = dir ? 63 - lane : lane;
      scl[i] = __expf(g); scl[64 + i] = __expf(tot - g); scl[128 + i] = pb;
      if (lane == 0) scl[192] = __expf(tot);
    }
  };
  issue_loads(dir ? nchunk - 1 : 0);
  store_tiles(0);
  __syncthreads();
  for (int st = 0; st < nchunk; ++st) {
    const int cidx = dir ? nchunk - 1 - st : st;
    const int row0 = seqbase + cidx * 64, buf = st & 1;
    const float* scl = (const float*)(g_shm + S_SC + buf * D_SC);
    bf16x8 ca[4], ct[2], cat[2];
#pragma unroll
    for (int ks = 0; ks < 4; ++ks) ca[ks] = __builtin_bit_cast(bf16x8, na[ks]);
#pragma unroll
    for (int ks = 0; ks < 2; ++ks) {
      ct[ks] = __builtin_bit_cast(bf16x8, mask_frag(nt[ks], arow, ks * 32 + fq * 8, dir, true));
      cat[ks] = __builtin_bit_cast(bf16x8, mask_frag(nat[ks], arow, ks * 32 + fq * 8, dir, false));
    }
    if (st + 1 < nchunk) issue_loads(dir ? cidx - 1 : cidx + 1);
    f32x4 a1[2];
#pragma unroll
    for (int n = 0; n < 2; ++n) a1[n] = (f32x4){0.f, 0.f, 0.f, 0.f};
#pragma unroll
    for (int ks = 0; ks < 4; ++ks)
#pragma unroll
      for (int n = 0; n < 2; ++n) {
        bf16x8 b = *(const bf16x8*)(g_shm + S_ST + (16 * n + fr) * 272 + (ks * 32 + fq * 8) * 2);
        a1[n] = __builtin_amdgcn_mfma_f32_16x16x32_bf16(ca[ks], b, a1[n], 0, 0, 0);
      }
    if (w < 4) {
      const int t0 = 16 * w + fq * 4;
      const f32x4 eg = *(const f32x4*)(scl + t0), be = *(const f32x4*)(scl + 128 + t0);
#pragma unroll
      for (int n = 0; n < 2; ++n) {
        u32x2 vv = *(const u32x2*)(g_shm + S_VT + buf * D_VT + (n * 16 + fr) * 144 + t0 * 2);
        float r0 = be[0] * (bf_lo(vv[0]) - eg[0] * a1[n][0]), r1 = be[1] * (bf_hi(vv[0]) - eg[1] * a1[n][1]);
        float r2 = be[2] * (bf_lo(vv[1]) - eg[2] * a1[n][2]), r3 = be[3] * (bf_hi(vv[1]) - eg[3] * a1[n][3]);
        u32x2 o; o[0] = pk_bf16(r0, r1); o[1] = pk_bf16(r2, r3);
        *(u32x2*)(g_shm + S_RT + (n * 16 + fr) * 144 + t0 * 2) = o;
      }
    }
    __syncthreads();
    {
      const int mt = w & 3, nn = w >> 2, t0 = mt * 16 + fq * 4;
      f32x4 vn = (f32x4){0.f, 0.f, 0.f, 0.f};
#pragma unroll
      for (int ks = 0; ks < 2; ++ks) {
        bf16x8 b = *(const bf16x8*)(g_shm + S_RT + (nn * 16 + fr) * 144 + (ks * 32 + fq * 8) * 2);
        vn = __builtin_amdgcn_mfma_f32_16x16x32_bf16(ct[ks], b, vn, 0, 0, 0);
      }
      const f32x4 el = *(const f32x4*)(scl + 64 + t0);
      u32x2 o; o[0] = pk_bf16(vn[0], vn[1]); o[1] = pk_bf16(vn[2], vn[3]);
      *(u32x2*)(g_shm + S_VN + (nn * 16 + fr) * 144 + t0 * 2) = o;
      u32x2 o2; o2[0] = pk_bf16(vn[0] * el[0], vn[1] * el[1]); o2[1] = pk_bf16(vn[2] * el[2], vn[3] * el[3]);
      *(u32x2*)(g_shm + S_VNS + (nn * 16 + fr) * 144 + t0 * 2) = o2;
    }
    __syncthreads();
    if (w >= 4) {
      const int t0 = (w - 4) * 16 + fq * 4;
      const f32x4 eg = *(const f32x4*)(scl + t0);
#pragma unroll
      for (int n = 0; n < 2; ++n) a1[n] = a1[n] * eg;
#pragma unroll
      for (int ks = 0; ks < 2; ++ks)
#pragma unroll
        for (int n = 0; n < 2; ++n) {
          bf16x8 b = *(const bf16x8*)(g_shm + S_VN + (n * 16 + fr) * 144 + (ks * 32 + fq * 8) * 2);
          a1[n] = __builtin_amdgcn_mfma_f32_16x16x32_bf16(cat[ks], b, a1[n], 0, 0, 0);
        }
#pragma unroll
      for (int n = 0; n < 2; ++n)
#pragma unroll
        for (int j = 0; j < 4; ++j)
          *(bf16_t*)(g_shm + S_OT + buf * D_OT + (t0 + j) * 80 + (n * 16 + fr) * 2) = (bf16_t)(pk_bf16(a1[n][j], 0.f) & 0xffffu);
    }
    {
      const float gl = scl[192];
#pragma unroll
      for (int n = 0; n < 2; ++n) S[n] = S[n] * gl;
#pragma unroll
      for (int ks = 0; ks < 2; ++ks) {
        bf16x8 a = *(const bf16x8*)(g_shm + S_KT + buf * D_KT + (16 * w + fr) * 144 + (ks * 32 + fq * 8) * 2);
#pragma unroll
        for (int n = 0; n < 2; ++n) {
          bf16x8 b = *(const bf16x8*)(g_shm + S_VNS + (n * 16 + fr) * 144 + (ks * 32 + fq * 8) * 2);
          S[n] = __builtin_amdgcn_mfma_f32_16x16x32_bf16(a, b, S[n], 0, 0, 0);
        }
      }
#pragma unroll
      for (int n = 0; n < 2; ++n) {
        u32x2 o; o[0] = pk_bf16(S[n][0], S[n][1]); o[1] = pk_bf16(S[n][2], S[n][3]);
        *(u32x2*)(g_shm + S_ST + (n * 16 + fr) * 272 + (16 * w + fq * 4) * 2) = o;
      }
    }
    if (st + 1 < nchunk) store_tiles(buf ^ 1);
    __syncthreads();
    __builtin_amdgcn_s_waitcnt(0x0F70); __builtin_amdgcn_sched_barrier(0);
    if (tid < 256) { const int r = tid >> 2, cc = tid & 3;
      *(u32x4*)(obuf + (size_t)(row0 + r) * old_ + dvoff + cc * 8) = *(const u32x4*)(g_shm + S_OT + buf * D_OT + r * 80 + cc * 16); }
  }
  __syncthreads();
  if (!lat) {
    float* dst = p.out + (size_t)NTOK * 1024 + (((size_t)sidx * 2 + dir) * 4 + h) * 16384;
#pragma unroll
    for (int n = 0; n < 2; ++n)
#pragma unroll
      for (int j = 0; j < 4; ++j) dst[(16 * w + fq * 4 + j) * 128 + q4 * 32 + n * 16 + fr] = S[n][j];
  }
}

__device__ __forceinline__ void phase4(const P& p) {
  const int b = BIDX(), G = GRIDX();
  if (G >= 256 && (G & 7) == 0) {
    const int x = b & 7, y = b >> 3;
    if (y < 16) scan_item(p, ((x * 4 + (y >> 2)) << 2) | (y & 3));
    else {
      const int ny = (G >> 3) - 16;
      for (int q = y - 16; q < 128; q += ny)
        scan_item(p, 128 + (((q >> 2) * 8 + x) << 2 | (q & 3)));
      cvt_loop(p, 1216 + (b - 128), 5440, G - 128, opaque_tid());
    }
  } else {
    for (int it = b; it < 128 + 1024; it += G) scan_item(p, it);
    cvt_loop(p, 1216 + b, 5440, G, opaque_tid());
  }
}

__device__ __forceinline__ void phase5(const P& p) {
  const int tid = opaque_tid();
  {
    const int lane = tid & 63, wid = tid >> 6;
    float* sh2 = (float*)g_shm;
    const float* mod = (const float*)(p.ws + OFF_MOD);
#pragma unroll 10
    for (int idx = tid; idx < 10240; idx += NTHREADS) { int lc = idx >> 10, k = idx & 1023; sh2[idx] = mod[(size_t)lc * 6144 + 3 * 1024 + k]; }
    __syncthreads();
    const bf16_t* Wgu = (const bf16_t*)(p.ws + OFF_WGU);
    float* sW = (float*)(p.ws + OFF_SW);
    for (int r = BIDX() * 8 + wid; r < 2 * 5632; r += GRIDX() * 8) {
      const int l = r / 5632, n = r % 5632;
      float a[5] = {0.f, 0.f, 0.f, 0.f, 0.f};
#pragma unroll
      for (int i = 0; i < 2; ++i) {
        const int k = i * 512 + lane * 8;
        float w[8]; unpack8(*(const u32x4*)(Wgu + ((size_t)l * 5632 + n) * 1024 + k), w);
#pragma unroll
        for (int c = 0; c < 5; ++c) {
          const float* s = sh2 + (l * 5 + c) * 1024 + k;
#pragma unroll
          for (int e = 0; e < 8; ++e) a[c] += w[e] * s[e];
        }
      }
#pragma unroll
      for (int c = 0; c < 5; ++c) { float v = wave_sum(a[c]); if (lane == 0) sW[((size_t)l * 5 + c) * 5632 + n] = v; }
    }
  }
  bf16_t* CAT = (bf16_t*)(p.ws + OFF_CAT); const bf16_t* OB = (const bf16_t*)(p.ws + OFF_OB); const bf16_t* GS = (const bf16_t*)(p.ws + OFF_GS);
  const int l16 = tid & 15, grp = tid >> 4;
  float gn[8];
#pragma unroll
  for (int e = 0; e < 8; ++e) gn[e] = p.o_norm_g[l16 * 8 + e];
  const int pstep = GRIDX() * 32;
  for (int pr = BIDX() * 32 + grp; pr < NTOK * 4; pr += 2 * pstep) {
    const int pr1 = pr + pstep; const bool has1 = pr1 < NTOK * 4; const int q1 = has1 ? pr1 : pr;
    const int row = pr >> 2, h = pr & 3, row1 = q1 >> 2, h1 = q1 & 3;
    const u32x4 la = *(const u32x4*)(CAT + (size_t)row * 1024 + h * 128 + l16 * 8), lb = *(const u32x4*)(OB + (size_t)row * 512 + h * 128 + l16 * 8), lg = *(const u32x4*)(GS + (size_t)row * 512 + h * 128 + l16 * 8);
    const u32x4 ma = *(const u32x4*)(CAT + (size_t)row1 * 1024 + h1 * 128 + l16 * 8), mb = *(const u32x4*)(OB + (size_t)row1 * 512 + h1 * 128 + l16 * 8), mg = *(const u32x4*)(GS + (size_t)row1 * 512 + h1 * 128 + l16 * 8);
    float a[8], b[8], g[8], c[8], d[8], f[8];
    unpack8(la, a); unpack8(lb, b); unpack8(lg, g); unpack8(ma, c); unpack8(mb, d); unpack8(mg, f);
    float ss = 0.f, st = 0.f;
#pragma unroll
    for (int e = 0; e < 8; ++e) { a[e] += b[e]; ss += a[e] * a[e]; c[e] += d[e]; st += c[e] * c[e]; }
    ss = sum16(ss); st = sum16(st);
    const float ri = rsqrtf(ss * (1.f / 128.f) + EPSF), rj = rsqrtf(st * (1.f / 128.f) + EPSF);
#pragma unroll
    for (int e = 0; e < 8; ++e) { a[e] = a[e] * ri * gn[e] * g[e]; c[e] = c[e] * rj * gn[e] * f[e]; }
    *(u32x4*)(CAT + (size_t)row * 1024 + h * 128 + l16 * 8) = pack8(a);
    if (has1) *(u32x4*)(CAT + (size_t)row1 * 1024 + h1 * 128 + l16 * 8) = pack8(c);
  }
}

__device__ __forceinline__ void phase9(const P& p) {
  const int tid = opaque_tid();
  const bf16_t* X = (const bf16_t*)p.out; const float* rsq = (const float*)(p.ws + OFF_RSQ); const float* mod = (const float*)(p.ws + OFF_MOD);
  bf16_t* MX = (bf16_t*)(p.ws + OFF_R1);
  float* rinv = (float*)g_shm;
  char* XS = g_shm + 256;
  const int c4 = tid & 255, half = tid >> 8;
  const int col = c4 * 4, win = 2 << (col >> 8), hw = win >> 1;
  for (int seg = BIDX(); seg < NTOK / 32; seg += GRIDX()) {
    const int row0 = seg * 32;
    int base, L; if (row0 < NCTX) { base = (row0 >> 8) << 8; L = 256; } else { base = NCTX + (((row0 - NCTX) >> 12) << 12); L = 4096; }
    const int p0 = row0 - base;
    __syncthreads();
#pragma unroll
    for (int i = 0; i < 12; ++i) {
      const int idx = tid + 512 * i, r = idx >> 7, cc = idx & 127, q = p0 - 8 + r;
      u32x4 v = (u32x4){0u, 0u, 0u, 0u};
      if (q >= 0 && q < L) v = *(const u32x4*)(X + (size_t)(base + q) * 1024 + cc * 8);
      *(u32x4*)(XS + r * 2048 + cc * 16) = v;
    }
    if (tid < 64) {
      int q = p0 - 16 + tid;
      if (q >= 0 && q < L) { int g = base + q; rinv[tid] = rsqrtf((rsq[g] + rsq[NTOK + g] + rsq[2 * NTOK + g] + rsq[3 * NTOK + g]) * (1.f / 1024.f) + EPSF); }
      else rinv[tid] = 0.f;
    }
    __syncthreads();
    const float* mc = mod + ((size_t)5 + row_cond(row0)) * 6144;
    f32x4 Gm;
    { f32x4 ng = *(const f32x4*)(p.norm_mix_g + 1024 + col), sc = *(const f32x4*)(mc + 1024 + col); Gm = ng * (sc + 1.f); }
    const int ps = p0 + half * 16;
    auto xn = [&](int q) -> f32x4 {
      const u32x2 xr = *(const u32x2*)(XS + (q - p0 + 8) * 2048 + col * 2);
      return (f32x4){bf_lo(xr[0]), bf_hi(xr[0]), bf_lo(xr[1]), bf_hi(xr[1])} * rinv[q - p0 + 16];
    };
    f32x4 sum = (f32x4){0.f, 0.f, 0.f, 0.f};
    for (int q = ps - hw; q < ps - hw + win; ++q) sum = sum + xn(q);
#pragma unroll 4
    for (int i = 0; i < 16; ++i) {
      const int t = ps + i;
      const int lo = max(t - hw, 0), hi = min(t - hw + win, L);
      const f32x4 xc = xn(t), xo = xn(t - hw), xi = xn(t - hw + win);
      f32x4 m = (sum * (1.f / (float)(hi - lo)) - xc) * Gm;
      u32x2 o; o[0] = pk_bf16(m[0], m[1]); o[1] = pk_bf16(m[2], m[3]);
      *(u32x2*)(MX + (size_t)(base + t) * 1024 + col) = o;
      sum = sum - xo + xi;
    }
  }
}

__device__ __forceinline__ void phase13(const P& p) {
  const int tid = opaque_tid(), lane = tid & 63, wid = tid >> 6;
  const float* rsq = (const float*)(p.ws + OFF_RSQ);
  const bf16_t* XF = (const bf16_t*)(p.ws + OFF_R1);
  const int rstep = GRIDX() * 8;
  for (int row = BIDX() * 8 + wid; row < NTOK; row += 2 * rstep) {
    const int row1 = row + rstep; const bool has1 = row1 < NTOK; const int r1 = has1 ? row1 : row;
    u32x2 xa[4], xb[4];
#pragma unroll
    for (int i = 0; i < 4; ++i) { const int k = i * 256 + lane * 4; xa[i] = *(const u32x2*)(XF + (size_t)row * 1024 + k); xb[i] = *(const u32x2*)(XF + (size_t)r1 * 1024 + k); }
    const float ria = rsqrtf((rsq[row] + rsq[NTOK + row] + rsq[2 * NTOK + row] + rsq[3 * NTOK + row]) * (1.f / 1024.f) + EPSF);
    const float rib = rsqrtf((rsq[r1] + rsq[NTOK + r1] + rsq[2 * NTOK + r1] + rsq[3 * NTOK + r1]) * (1.f / 1024.f) + EPSF);
#pragma unroll
    for (int i = 0; i < 4; ++i) {
      const int k = i * 256 + lane * 4;
      const f32x4 g = *(const f32x4*)(p.final_g + k);
      const f32x4 va = (f32x4){bf_lo(xa[i][0]), bf_hi(xa[i][0]), bf_lo(xa[i][1]), bf_hi(xa[i][1])};
      const f32x4 vb = (f32x4){bf_lo(xb[i][0]), bf_hi(xb[i][0]), bf_lo(xb[i][1]), bf_hi(xb[i][1])};
      *(f32x4*)(p.out + (size_t)row * 1024 + k) = va * ria * g;
      if (has1) *(f32x4*)(p.out + (size_t)row1 * 1024 + k) = vb * rib * g;
    }
  }
}

constexpr int NPHASE = 14;
template <int LO, int HI>
__global__ void __launch_bounds__(NTHREADS, 2) fwd_kernel(P p) {
  p.wv = __builtin_amdgcn_readfirstlane((int)(threadIdx.x >> 6));
  if constexpr (HI - LO > 1) { if (p.phase_lo == 0x7fffffff) cg::this_grid().sync();
    grid_bar_init(p); }
#define PH(k, call) if constexpr (LO <= (k) && (k) < HI) { if constexpr ((k) > LO) { grid_bar(p); } call; }
  PH(0, phase0(p))
  PH(1, phase1(p))
  PH(2, gemm_inproj(p))
  PH(3, phase3(p))
  PH(4, phase4(p))
  PH(5, phase5(p))
  PH(6, gemm_resid(p, 0, 0, (const bf16_t*)(p.ws + OFF_CAT), 1024, (const bf16_t*)(p.ws + OFF_WOUT), 1024, 16, (bf16_t*)(p.ws + OFF_R1)))
  PH(7, gemm_ffn_gu(p, 0, (const bf16_t*)(p.ws + OFF_R1)))
  PH(8, gemm_resid(p, 1, 0, (const bf16_t*)(p.ws + OFF_ACT), 2816, (const bf16_t*)(p.ws + OFF_WDN), 2816, 44, (bf16_t*)(p.ws + OFF_R1)))
  PH(9, phase9(p))
  PH(10, gemm_resid(p, 2, 1, (const bf16_t*)(p.ws + OFF_R1), 1024, (const bf16_t*)(p.ws + OFF_WPOOL), 256, 4, (bf16_t*)(p.ws + OFF_R1)))
  PH(11, gemm_ffn_gu(p, 1, (const bf16_t*)(p.ws + OFF_R1)))
  PH(12, gemm_resid(p, 1, 1, (const bf16_t*)(p.ws + OFF_ACT), 2816, (const bf16_t*)(p.ws + OFF_WDN) + (size_t)1024 * 2816, 2816, 44, (bf16_t*)(p.ws + OFF_R1)))
  PH(13, phase13(p))
#undef PH
}

__global__ void cks_kernel(const u32* ptr, size_t nwords, unsigned long long* slot) {
  unsigned long long s = 0;
  for (size_t i = (size_t)blockIdx.x * blockDim.x + threadIdx.x; i < nwords; i += (size_t)gridDim.x * blockDim.x) s += (unsigned long long)ptr[i] * (unsigned long long)((i & 1023) + 1);
  for (int o = 32; o > 0; o >>= 1) s += __shfl_xor(s, o, 64);
  if ((threadIdx.x & 63) == 0) atomicAdd(slot, s);
}
__global__ void cmp_kernel(const unsigned long long* slots, int nbuf, float* out, int n_y, int n_all) {
  int code = 0;
  for (int b = 0; b < nbuf; ++b) if (slots[b] != slots[64 + b]) { code = b + 1; break; }
  const float c = sqrtf(100.f * (float)code);
  for (int i = blockIdx.x * blockDim.x + threadIdx.x; i < n_all; i += gridDim.x * blockDim.x) out[i] = i < n_y ? c : 0.f;
}

__global__ void sanitize_kernel(float* o, int n) {
  for (int i = blockIdx.x * blockDim.x + threadIdx.x; i < n; i += gridDim.x * blockDim.x) { float v = o[i]; if (!(fabsf(v) < 3.0e38f)) o[i] = 0.f; }
}

extern "C" void kernel_launch(void* const* d_in, const int* in_sizes, int n_in, void* d_out, int out_size, void* d_ws, size_t ws_size, hipStream_t stream) {
  static int grid_blocks = 0;
#if COOP
  const void* kfn = (const void*)fwd_kernel<0, NPHASE>;
#else
  const void* kfns[NPHASE] = {(const void*)fwd_kernel<0, 1>, (const void*)fwd_kernel<1, 2>, (const void*)fwd_kernel<2, 3>, (const void*)fwd_kernel<3, 4>,
                              (const void*)fwd_kernel<4, 5>, (const void*)fwd_kernel<5, 6>, (const void*)fwd_kernel<6, 7>, (const void*)fwd_kernel<7, 8>,
                              (const void*)fwd_kernel<8, 9>, (const void*)fwd_kernel<9, 10>, (const void*)fwd_kernel<10, 11>, (const void*)fwd_kernel<11, 12>,
                              (const void*)fwd_kernel<12, 13>, (const void*)fwd_kernel<13, 14>};
#endif
  if (!grid_blocks) {
    int dev = 0, cus = 0;
    (void)hipGetDevice(&dev);
    (void)hipDeviceGetAttribute(&cus, hipDeviceAttributeMultiprocessorCount, dev);
#if COOP
    (void)hipFuncSetAttribute(kfn, hipFuncAttributeMaxDynamicSharedMemorySize, LDS_BYTES);
    int per_cu = 0;
    (void)hipOccupancyMaxActiveBlocksPerMultiprocessor(&per_cu, kfn, NTHREADS, LDS_BYTES);
    if (per_cu < 1) fprintf(stderr, "occupancy query returned %d\n", per_cu);
#else
    for (int i = 0; i < NPHASE; ++i) (void)hipFuncSetAttribute(kfns[i], hipFuncAttributeMaxDynamicSharedMemorySize, LDS_BYTES);
#endif
    grid_blocks = cus >= 8 ? (cus / 8) * 8 : 256;
  }
  P p{};
  p.x_prompt = (const float*)d_in[0]; p.x_sample = (const float*)d_in[1]; p.state = (const float*)d_in[2]; p.c = (const float*)d_in[3];
  p.c_ctx = (const float*)d_in[4]; p.norm_mix_g = (const float*)d_in[5]; p.norm_ffn_g = (const float*)d_in[6]; p.w_ada = (const float*)d_in[7];
  p.b_ada = (const float*)d_in[8]; p.w_in = (const float*)d_in[9]; p.conv_qkv = (const float*)d_in[10]; p.a_log = (const float*)d_in[11];
  p.dt_bias = (const float*)d_in[12]; p.o_norm_g = (const float*)d_in[13]; p.conv_b = (const float*)d_in[14]; p.w_out = (const float*)d_in[15];
  p.w_pool = (const float*)d_in[16]; p.pool_scale = (const float*)d_in[17]; p.w_gate = (const float*)d_in[18]; p.w_up = (const float*)d_in[19];
  p.ffn_conv = (const float*)d_in[20]; p.w_down = (const float*)d_in[21]; p.final_g = (const float*)d_in[22];
  p.out = (float*)d_out; p.ws = (char*)d_ws; p.nblk = grid_blocks; p.wv = 0;
#if COOP
  p.phase_lo = 0; p.phase_hi = NPHASE;
  void* args[] = {&p};
  (void)hipMemsetAsync((char*)d_ws + OFF_BAR, 0, XCD_BAR_WORDS * 4, stream);
  hipError_t e = hipLaunchCooperativeKernel(kfn, dim3(grid_blocks), dim3(NTHREADS), args, LDS_BYTES, stream);
  if (e != hipSuccess) fprintf(stderr, "cooperative launch failed: %s (grid %d)\n", hipGetErrorString(e), grid_blocks);
#else
  p.phase_lo = 0; p.phase_hi = 1;
  void* args[] = {&p};
#ifdef DBG
  {
    const size_t OFF_DBG = (size_t)255 * 1024 * 1024;
    unsigned long long* slots = (unsigned long long*)((char*)d_ws + OFF_DBG);
    (void)hipMemsetAsync(slots, 0, 4096, stream);
    struct CB { int after; const void* ptr; size_t bytes; };
    char* ws = (char*)d_ws; char* o = (char*)d_out;
    const CB cbs[] = {
      {1, ws + OFF_MOD, (size_t)2 * 5 * 6144 * 4}, {1, ws + OFF_WIN, OFF_SMALL}, {1, ws + OFF_SW, (size_t)2 * 5 * 5632 * 4}, {1, ws + OFF_PE, (size_t)64 * 512 * 4},
      {1, ws + OFF_G, (size_t)NTOK * 32}, {1, ws + OFF_BETA, (size_t)NTOK * 32}, {1, o, (size_t)NTOK * 4096}, {1, ws + OFF_R1, SZ_R1},
      {2, ws + OFF_Q, SZ_QKV}, {2, ws + OFF_K, SZ_QKV}, {2, ws + OFF_V, SZ_QKV}, {2, ws + OFF_GS, SZ_QKV},
      {3, ws + OFF_TP, (size_t)1536 * 8192}, {3, ws + OFF_AP, (size_t)1536 * 8192},
      {4, ws + OFF_OB, SZ_QKV}, {4, o + (size_t)NTOK * 4096, (size_t)32 * 2 * 4 * 16384 * 4},
      {5, ws + OFF_CAT, SZ_R1},
      {6, ws + OFF_R1, SZ_R1}, {6, o, (size_t)NTOK * 4096}, {6, ws + OFF_RSQ, (size_t)4 * NTOK * 4}};
    const int ncb = sizeof(cbs) / sizeof(cbs[0]);
    for (int run = 0; run < 2; ++run) {
      (void)hipMemsetAsync(d_ws, run ? 0xAA : 0x55, OFF_DBG, stream);
      (void)hipMemsetAsync(d_out, run ? 0xAA : 0x55, (size_t)out_size * 4, stream);
      for (int ph = 0; ph <= 6; ++ph) {
        (void)hipLaunchKernel(kfns[ph], dim3(grid_blocks), dim3(NTHREADS), args, LDS_BYTES, stream);
        for (int b = 0; b < ncb; ++b) if (cbs[b].after == ph)
          hipLaunchKernelGGL(cks_kernel, dim3(1024), dim3(256), 0, stream, (const u32*)cbs[b].ptr, cbs[b].bytes / 4, slots + run * 64 + b);
      }
    }
    hipLaunchKernelGGL(cmp_kernel, dim3(1024), dim3(256), 0, stream, (const unsigned long long*)slots, ncb, (float*)d_out, NTOK * 1024, out_size);
  }
#else
  for (int ph = 0; ph <= STOP_AFTER; ++ph) {
    hipError_t e = hipLaunchKernel(kfns[ph], dim3(grid_blocks), dim3(NTHREADS), args, LDS_BYTES, stream);
    if (e != hipSuccess) fprintf(stderr, "launch %d failed: %s\n", ph, hipGetErrorString(e));
  }
#ifdef SANITIZE
  hipLaunchKernelGGL(sanitize_kernel, dim3(1024), dim3(256), 0, stream, (float*)d_out, out_size);
#endif
#endif
#endif
}
```
